# Optimizing an MI355X kernel written in HIP

```python
import math
import jax, jax.numpy as jnp
from jax import lax
import numpy as np

D_MODEL = 1024
BATCH = 2
SEQ = 16384
DEPTH = 2

N_MEM = 256
D_MIX = 2 * D_MODEL
GROUP = D_MIX // 4
A_HEADS = 4
A_DK = GROUP // A_HEADS
A_DV = GROUP // A_HEADS
B_HEADS = 4
B_DQK = GROUP // B_HEADS // 2
B_DV = GROUP // B_HEADS
C_HEADS = 4
C_D = GROUP // C_HEADS
X_HEADS = 4
X_D = GROUP // X_HEADS

ROPE_THETA = 500000.0
ROPE_DIM = B_DQK // 4
CHUNK = 64
Q_BLOCK = 128
CONV_K = 4
EPS = 1e-6
NEG = -1e30
TINY = 1e-30

IN_SIZES = (GROUP, GROUP, GROUP, GROUP,
            GROUP, GROUP, GROUP, GROUP,
            GROUP, GROUP, GROUP, GROUP, C_HEADS, C_HEADS, GROUP,
            GROUP, GROUP)
N_IN = sum(IN_SIZES)

kernel_name = 'hymba_hgrn2_diffattn_mlstm_memxattn'


def rms_norm(x, g):
    xf = x.astype(jnp.float32)
    y = xf * lax.rsqrt(jnp.mean(xf * xf, axis=-1, keepdims=True) + EPS)
    return (y * g.astype(jnp.float32)).astype(x.dtype)


def split_cols(p, sizes):
    outs, off = [], 0
    for s in sizes:
        outs.append(p[..., off:off + s])
        off += s
    return outs


def partial_rope(x, cos, sin):
    half = ROPE_DIM // 2
    x1 = x[..., :half].astype(jnp.float32)
    x2 = x[..., half:ROPE_DIM].astype(jnp.float32)
    rot = jnp.concatenate([x1 * cos - x2 * sin, x2 * cos + x1 * sin], axis=-1).astype(x.dtype)
    return jnp.concatenate([rot, x[..., ROPE_DIM:]], axis=-1)


def causal_dwconv(x, w, b):
    y = lax.conv_general_dilated(x, w[:, None, :].astype(x.dtype), window_strides=(1,),
                                 padding=((CONV_K - 1, 0),),
                                 dimension_numbers=('NWC', 'WIO', 'NWC'),
                                 feature_group_count=x.shape[-1])
    return y + b.astype(x.dtype)


def to_chunks(t):
    bsz, s = t.shape[:2]
    t = t.reshape((bsz, s // CHUNK, CHUNK) + t.shape[2:])
    return jnp.transpose(t, (1, 0, 3, 2) + tuple(range(4, t.ndim)))


def from_chunks(o):
    nc, bsz, h, c, d = o.shape
    return jnp.transpose(o, (1, 0, 3, 2, 4)).reshape(bsz, nc * c, h, d)


def hgrn2_scan(q, k, v, log_f):
    out_dtype = v.dtype
    qc, kc, vc, gc = [to_chunks(t.astype(jnp.float32)) for t in (q, k, v, log_f)]
    bsz, h, dk, dv = q.shape[0], q.shape[2], q.shape[3], v.shape[3]
    causal = jnp.tril(jnp.ones((CHUNK, CHUNK), dtype=bool))[:, :, None]

    def step(state, inp):
        qi, ki, vi, gi = inp
        b = jnp.cumsum(gi, axis=2)
        rel = b[:, :, :, None, :] - b[:, :, None, :, :]
        decay = jnp.where(causal, jnp.exp(jnp.where(causal, rel, 0.0)), 0.0)
        attn = jnp.einsum('bhtk,bhsk,bhtsk->bhts', qi, ki, decay)
        o = (jnp.einsum('bhts,bhsv->bhtv', attn, vi)
             + jnp.einsum('bhtk,bhkv->bhtv', qi * jnp.exp(b), state))
        b_last = b[:, :, -1]
        state = (jnp.exp(b_last)[..., None] * state
                 + jnp.einsum('bhsk,bhsv->bhkv', ki * jnp.exp(b_last[:, :, None] - b), vi))
        return state, o

    s0 = jnp.zeros((bsz, h, dk, dv), jnp.float32)
    _, o = lax.scan(step, s0, (qc, kc, vc, gc))
    return from_chunks(o).astype(out_dtype)


def mlstm_scan(q, k, v, log_i, log_f):
    out_dtype = v.dtype
    qc, kc, vc = [to_chunks(t.astype(jnp.float32)) for t in (q, k, v)]
    ic, fc = [to_chunks(t.astype(jnp.float32)) for t in (log_i, log_f)]
    bsz, h, d = q.shape[0], q.shape[2], q.shape[3]
    causal = jnp.tril(jnp.ones((CHUNK, CHUNK), dtype=bool))

    def step(carry, inp):
        cmat, n, m = carry
        qi, ki, vi, li, lf = inp
        b = jnp.cumsum(lf, axis=-1)
        dmat = jnp.where(causal, b[..., :, None] - b[..., None, :] + li[..., None, :], NEG)
        inter = b + m[..., None]
        m_t = jnp.maximum(jnp.max(dmat, axis=-1), inter)
        w = jnp.where(causal, jnp.exp(dmat - m_t[..., None]), 0.0)
        w_inter = jnp.exp(inter - m_t)
        s = jnp.einsum('bhtd,bhsd->bhts', qi, ki) * w
        num = (jnp.einsum('bhts,bhsv->bhtv', s, vi)
               + w_inter[..., None] * jnp.einsum('bhtk,bhvk->bhtv', qi, cmat))
        nq = jnp.sum(s, axis=-1) + w_inter * jnp.einsum('bhtk,bhk->bht', qi, n)
        hout = num / jnp.maximum(jnp.abs(nq), jnp.exp(-m_t))[..., None]
        b_last = b[..., -1]
        g = b_last[..., None] - b + li
        m_new = jnp.maximum(b_last + m, jnp.max(g, axis=-1))
        wg = jnp.exp(g - m_new[..., None])
        dec = jnp.exp(b_last + m - m_new)
        cmat = dec[..., None, None] * cmat + jnp.einsum('bhs,bhsv,bhsk->bhvk', wg, vi, ki)
        n = dec[..., None] * n + jnp.einsum('bhs,bhsk->bhk', wg, ki)
        return (cmat, n, m_new), hout

    init = (jnp.zeros((bsz, h, d, d), jnp.float32), jnp.zeros((bsz, h, d), jnp.float32),
            jnp.zeros((bsz, h), jnp.float32))
    _, o = lax.scan(step, init, (qc, kc, vc, ic, fc))
    return from_chunks(o).astype(out_dtype)


def diff_attention(q, k, v, lam):
    bsz, s, h = q.shape[:3]
    nb = s // Q_BLOCK
    qb = q.reshape(bsz, nb, Q_BLOCK, h, 2, q.shape[-1]).transpose(1, 0, 2, 3, 4, 5)
    kpos = jnp.arange(s)

    def block(args):
        qi, j = args
        sc = jnp.einsum('bqhcd,bkhcd->bhcqk', qi, k).astype(jnp.float32)
        qpos = j * Q_BLOCK + jnp.arange(Q_BLOCK)
        sc = jnp.where(qpos[:, None] >= kpos[None, :], sc, NEG)
        p = jax.nn.softmax(sc, axis=-1)
        a = (p[:, :, 0] - lam * p[:, :, 1]).astype(v.dtype)
        return jnp.einsum('bhqk,bkhd->bqhd', a, v)

    o = lax.map(block, (qb, jnp.arange(nb)))
    return o.transpose(1, 0, 2, 3, 4).reshape(bsz, s, h, v.shape[-1])


def hybrid_layer(x, mem, cos, sin, layer_idx, lb, norm_g, w_in, mlstm_gate_b, hgrn_norm_g,
                 diff_qk_norm_g, diff_lambda, diff_subln_g, mlstm_conv_w, mlstm_conv_b,
                 mlstm_norm_g, mem_norm_g, w_mem_kv, xattn_qk_norm_g, w_out):
    bsz, s, _ = x.shape
    h = rms_norm(x, norm_g)
    proj = h @ w_in.astype(h.dtype)
    (a_q, a_f, a_i, a_g, b_q, b_k, b_v, b_g,
     c_q, c_k, c_v, c_o, c_i, c_f, c_g, x_q, x_g) = split_cols(proj, IN_SIZES)

    qa = jax.nn.silu(a_q).reshape(bsz, s, A_HEADS, A_DK) * (A_DK ** -0.5)
    fa = a_f.astype(jnp.float32).reshape(bsz, s, A_HEADS, A_DK)
    lbh = lb.astype(jnp.float32).reshape(A_HEADS, A_DK)
    f_gate = lbh + (1.0 - lbh) * jax.nn.sigmoid(fa)
    log_f = jnp.log(jnp.maximum(f_gate, TINY))
    ka = (1.0 - lbh) * jax.nn.sigmoid(-fa)
    oa = hgrn2_scan(qa, ka, a_i.reshape(bsz, s, A_HEADS, A_DV), log_f)
    ya = rms_norm(oa, hgrn_norm_g).reshape(bsz, s, GROUP) * jax.nn.silu(a_g)

    qb = rms_norm(b_q.reshape(bsz, s, B_HEADS, 2, B_DQK), diff_qk_norm_g[0])
    kb = rms_norm(b_k.reshape(bsz, s, B_HEADS, 2, B_DQK), diff_qk_norm_g[1])
    qb = partial_rope(qb, cos, sin) * (B_DQK ** -0.5)
    kb = partial_rope(kb, cos, sin)
    lam_init = 0.8 - 0.6 * math.exp(-0.3 * layer_idx)
    lp = diff_lambda.astype(jnp.float32)
    lam = jnp.exp(jnp.sum(lp[0] * lp[1])) - jnp.exp(jnp.sum(lp[2] * lp[3])) + lam_init
    ob = diff_attention(qb, kb, b_v.reshape(bsz, s, B_HEADS, B_DV), lam)
    yb = (rms_norm(ob, diff_subln_g) * (1.0 - lam_init)).reshape(bsz, s, GROUP) * jax.nn.silu(b_g)

    qk = jax.nn.silu(causal_dwconv(jnp.concatenate([c_q, c_k], axis=-1), mlstm_conv_w, mlstm_conv_b))
    qc = qk[..., :GROUP].reshape(bsz, s, C_HEADS, C_D)
    kc = qk[..., GROUP:].reshape(bsz, s, C_HEADS, C_D) * (C_D ** -0.5)
    vc = c_v.reshape(bsz, s, C_HEADS, C_D)
    gb = mlstm_gate_b.astype(jnp.float32)
    log_i = c_i.astype(jnp.float32) + gb[:C_HEADS]
    log_fc = jax.nn.log_sigmoid(c_f.astype(jnp.float32) + gb[C_HEADS:])
    hc = mlstm_scan(qc, kc, vc, log_i, log_fc)
    hc = jax.nn.sigmoid(c_o).reshape(bsz, s, C_HEADS, C_D) * hc
    yc = rms_norm(hc, mlstm_norm_g).reshape(bsz, s, GROUP) * jax.nn.silu(c_g)

    mn = rms_norm(mem, mem_norm_g)
    kv = mn @ w_mem_kv.astype(mn.dtype)
    km = rms_norm(kv[..., :GROUP].reshape(bsz, N_MEM, X_HEADS, X_D), xattn_qk_norm_g[1])
    vm = kv[..., GROUP:].reshape(bsz, N_MEM, X_HEADS, X_D)
    qx = rms_norm(x_q.reshape(bsz, s, X_HEADS, X_D), xattn_qk_norm_g[0]) * (X_D ** -0.5)
    px = jax.nn.softmax(jnp.einsum('bqhd,bmhd->bhqm', qx, km).astype(jnp.float32), axis=-1)
    ox = jnp.einsum('bhqm,bmhd->bqhd', px.astype(vm.dtype), vm).reshape(bsz, s, GROUP)
    yx = ox * jax.nn.silu(x_g)

    y = jnp.concatenate([ya, yb, yc, yx], axis=-1).astype(x.dtype) @ w_out.astype(x.dtype)
    return x + y


def setup_inputs(seed: int = 0) -> dict:
    key = jax.random.key(seed)
    ks = jax.random.split(key, 20)
    f32 = jnp.float32
    nrm = lambda k, shape: jax.random.normal(k, shape, f32)
    x = nrm(ks[0], (BATCH, SEQ, D_MODEL))
    mem = nrm(ks[1], (BATCH, N_MEM, D_MODEL))
    offs = jax.random.randint(ks[2], (BATCH, 1), 0, 4096, dtype=jnp.int32)
    positions = offs + jnp.arange(SEQ, dtype=jnp.int32)[None, :]
    norm_g = 1.0 + 0.02 * nrm(ks[3], (DEPTH, D_MODEL))
    w_in = nrm(ks[4], (DEPTH, D_MODEL, N_IN)) * (D_MODEL ** -0.5)
    mlstm_gate_b = jnp.concatenate([
        0.1 * nrm(ks[5], (DEPTH, C_HEADS)),
        jnp.linspace(3.0, 6.0, C_HEADS, dtype=f32)[None, :] + 0.1 * nrm(ks[6], (DEPTH, C_HEADS))], axis=-1)
    hgrn_lb_logits = nrm(ks[7], (DEPTH, GROUP))
    hgrn_norm_g = 1.0 + 0.02 * nrm(ks[8], (DEPTH, A_DV))
    diff_qk_norm_g = 1.0 + 0.02 * nrm(ks[9], (DEPTH, 2, B_DQK))
    diff_lambda = 0.1 * nrm(ks[10], (DEPTH, 4, B_DQK))
    diff_subln_g = 1.0 + 0.02 * nrm(ks[11], (DEPTH, B_DV))
    mlstm_conv_w = nrm(ks[12], (DEPTH, CONV_K, 2 * GROUP)) * (CONV_K ** -0.5)
    mlstm_conv_b = 0.01 * nrm(ks[13], (DEPTH, 2 * GROUP))
    mlstm_norm_g = 1.0 + 0.02 * nrm(ks[14], (DEPTH, C_D))
    mem_norm_g = 1.0 + 0.02 * nrm(ks[15], (DEPTH, D_MODEL))
    w_mem_kv = nrm(ks[16], (DEPTH, D_MODEL, 2 * GROUP)) * (D_MODEL ** -0.5)
    xattn_qk_norm_g = 1.0 + 0.02 * nrm(ks[17], (DEPTH, 2, X_D))
    w_out = nrm(ks[18], (DEPTH, D_MIX, D_MODEL)) * (D_MIX ** -0.5)
    return {'x': x, 'mem': mem, 'positions': positions, 'norm_g': norm_g, 'w_in': w_in,
            'mlstm_gate_b': mlstm_gate_b, 'hgrn_lb_logits': hgrn_lb_logits,
            'hgrn_norm_g': hgrn_norm_g, 'diff_qk_norm_g': diff_qk_norm_g,
            'diff_lambda': diff_lambda, 'diff_subln_g': diff_subln_g,
            'mlstm_conv_w': mlstm_conv_w, 'mlstm_conv_b': mlstm_conv_b,
            'mlstm_norm_g': mlstm_norm_g, 'mem_norm_g': mem_norm_g, 'w_mem_kv': w_mem_kv,
            'xattn_qk_norm_g': xattn_qk_norm_g, 'w_out': w_out}


def reference(x, mem, positions, norm_g, w_in, mlstm_gate_b, hgrn_lb_logits, hgrn_norm_g,
              diff_qk_norm_g, diff_lambda, diff_subln_g, mlstm_conv_w, mlstm_conv_b,
              mlstm_norm_g, mem_norm_g, w_mem_kv, xattn_qk_norm_g, w_out):
    inv_freq = ROPE_THETA ** (-jnp.arange(0, ROPE_DIM, 2, dtype=jnp.float32) / ROPE_DIM)
    ang = positions.astype(jnp.float32)[..., None] * inv_freq
    cos = jnp.cos(ang)[:, :, None, None, :]
    sin = jnp.sin(ang)[:, :, None, None, :]
    sm = jax.nn.softmax(hgrn_lb_logits.astype(jnp.float32), axis=0)
    lower_bounds = jnp.cumsum(sm, axis=0) - sm[0]
    for l in range(DEPTH):
        x = hybrid_layer(x, mem, cos, sin, l, lower_bounds[l], norm_g[l], w_in[l],
                         mlstm_gate_b[l], hgrn_norm_g[l], diff_qk_norm_g[l], diff_lambda[l],
                         diff_subln_g[l], mlstm_conv_w[l], mlstm_conv_b[l], mlstm_norm_g[l],
                         mem_norm_g[l], w_mem_kv[l], xattn_qk_norm_g[l], w_out[l])
    return x
```

```cpp
#include <hip/hip_runtime.h>
#include <hip/hip_cooperative_groups.h>
#include <cstdio>
#include <cstdint>
#include <cmath>
namespace cg = cooperative_groups;

#define DI __device__ __forceinline__
typedef unsigned short bf16_t;
typedef short bf16x8 __attribute__((ext_vector_type(8)));
typedef short s16x4 __attribute__((ext_vector_type(4)));
typedef float f32x2 __attribute__((ext_vector_type(2)));
typedef float f32x4 __attribute__((ext_vector_type(4)));
typedef float f32x16 __attribute__((ext_vector_type(16)));
typedef __bf16 bf16x2v __attribute__((ext_vector_type(2)));
typedef unsigned u32x2 __attribute__((ext_vector_type(2)));
typedef unsigned u32x4 __attribute__((ext_vector_type(4)));

constexpr int SEQ = 16384, DM = 1024, NBATCH = 2, MP = 16384;
constexpr int NIN = 7680, NINO = 7688, DMIX = 2048;
constexpr int NTHR = 512;
constexpr float EPS = 1e-6f;
constexpr int LDS_BYTES = 143360;
constexpr int LDS_UNIT_OFF = 143344;

constexpr size_t WS_CTL   = 0;
constexpr size_t WS_WIN   = 4096;
constexpr size_t WS_WOUT  = WS_WIN  + (size_t)2 * NIN * DM * 2;
constexpr size_t WS_WKV   = WS_WOUT + (size_t)2 * DM * DMIX * 2;
constexpr size_t WS_MNB   = WS_WKV  + (size_t)2 * DM * DM * 2;
constexpr size_t WS_KMB   = WS_MNB  + (size_t)512 * DM * 2;
constexpr size_t WS_VMT   = WS_KMB  + (size_t)2 * 512 * 512 * 2;
constexpr size_t WS_COS   = WS_VMT  + (size_t)2 * 2 * 512 * 256 * 2;
constexpr size_t WS_SIN   = WS_COS  + (size_t)32768 * 8 * 4;
constexpr size_t WS_LB    = WS_SIN  + (size_t)32768 * 8 * 4;
constexpr size_t WS_XB    = WS_LB   + 4096;
constexpr size_t WS_RSTD  = WS_XB   + (size_t)MP * DM * 2;
constexpr size_t WS_GATES = WS_RSTD + (size_t)MP * 4;
constexpr size_t SZ512    = (size_t)MP * 512 * 2;
constexpr size_t WS_QA    = WS_GATES + (size_t)MP * 8 * 4;
constexpr size_t WS_LF    = WS_QA + SZ512;
constexpr size_t WS_VAT   = WS_LF + SZ512;
constexpr size_t WS_QB    = WS_VAT + SZ512;
constexpr size_t WS_KB    = WS_QB + SZ512;
constexpr size_t WS_VBT   = WS_KB + SZ512;
constexpr size_t WS_CQ    = WS_VBT + SZ512;
constexpr size_t WS_CK    = WS_CQ + SZ512;
constexpr size_t WS_CVT   = WS_CK + SZ512;
constexpr size_t WS_OG    = WS_CVT + SZ512;
constexpr size_t WS_QX    = WS_OG + SZ512;
constexpr size_t WS_Y     = WS_QX + SZ512;
constexpr size_t WS_END   = WS_Y + (size_t)MP * DMIX * 2;

struct Params {
    const float* in[18];
    float* out;
    unsigned char* ws;
    float inv_freq[8];
    int mode;
    int pad;
};

DI float bf2f(bf16_t v) { return __uint_as_float(((unsigned)v) << 16); }
DI unsigned pk2(float lo, float hi) { f32x2 v = {lo, hi}; bf16x2v b = __builtin_convertvector(v, bf16x2v); return __builtin_bit_cast(unsigned, b); }
DI bf16_t f2bf(float x) { return (bf16_t)(pk2(x, 0.f) & 0xffffu); }
DI float wave_sum(float v) {
#pragma unroll
    for (int o = 1; o < 64; o <<= 1) v += __shfl_xor(v, o);
    return v;
}
DI float sigmoidf_(float x) { return 1.f / (1.f + __expf(-x)); }
DI float siluf_(float x) { return x / (1.f + __expf(-x)); }
DI f32x4 mfma16(bf16x8 a, bf16x8 b, f32x4 c) { return __builtin_amdgcn_mfma_f32_16x16x32_bf16(a, b, c, 0, 0, 0); }
DI f32x16 mfma32(bf16x8 a, bf16x8 b, f32x16 c) { return __builtin_amdgcn_mfma_f32_32x32x16_bf16(a, b, c, 0, 0, 0); }
DI int opaque(int x) { asm volatile("" : "+v"(x)); return x; }
DI int crow(int r, int h2) { return (r & 3) + 8 * (r >> 2) + 4 * h2; }
DI void unpack8(u32x4 u, float* f) {
    f[0] = __uint_as_float(u.x << 16); f[1] = __uint_as_float(u.x & 0xffff0000u);
    f[2] = __uint_as_float(u.y << 16); f[3] = __uint_as_float(u.y & 0xffff0000u);
    f[4] = __uint_as_float(u.z << 16); f[5] = __uint_as_float(u.z & 0xffff0000u);
    f[6] = __uint_as_float(u.w << 16); f[7] = __uint_as_float(u.w & 0xffff0000u);
}
DI u32x4 pack8(const float* f) { u32x4 o; o.x = pk2(f[0], f[1]); o.y = pk2(f[2], f[3]); o.z = pk2(f[4], f[5]); o.w = pk2(f[6], f[7]); return o; }

DI void transpose_tile(const float* src, int ldsrc, int srccol0, const float* g, bf16_t* dst, int lddst, int k0, int n0, float* T, int tid) {
    const int n = tid & 63, kk = tid >> 6;
#pragma unroll
    for (int i = 0; i < 8; ++i) { const int k = kk + 8 * i; float v = src[(size_t)(k0 + k) * ldsrc + srccol0 + n]; if (g) v *= g[k0 + k]; T[k * 65 + n] = v; }
    __syncthreads();
    const int nn = tid >> 3, kc = tid & 7;
    float f[8];
#pragma unroll
    for (int i = 0; i < 8; ++i) f[i] = T[(8 * kc + i) * 65 + nn];
    *(u32x4*)(dst + (size_t)(n0 + nn) * lddst + k0 + 8 * kc) = pack8(f);
    __syncthreads();
}

DI void phase0(const Params& P, unsigned char* lds) {
    const int tid = opaque((int)threadIdx.x), bid = blockIdx.x, G = gridDim.x;
    unsigned char* ws = P.ws;
    float* T = (float*)lds;
    if (bid == 0) { for (int i = tid; i < 1024; i += NTHR) ((unsigned*)(ws + WS_CTL))[i] = 0u; }
    constexpr int T_IN = 16 * 120, T_OUT = 32 * 16, T_KV = 16 * 16;
    constexpr int NT = 2 * (T_IN + T_OUT + T_KV);
    for (int it = bid; it < NT; it += G) {
        int r = it; const int l = r / (T_IN + T_OUT + T_KV); r -= l * (T_IN + T_OUT + T_KV);
        if (r < T_IN) { const int kb = r / 120, nb = r % 120, n0 = nb * 64; const int sc = n0 < 6144 ? n0 : n0 + 8;
            transpose_tile(P.in[4] + (size_t)l * DM * NINO, NINO, sc, P.in[3] + l * DM, (bf16_t*)(ws + WS_WIN) + (size_t)l * NIN * DM, DM, kb * 64, n0, T, tid); continue; }
        r -= T_IN;
        if (r < T_OUT) { const int kb = r / 16, nb = r % 16;
            transpose_tile(P.in[17] + (size_t)l * DMIX * DM, DM, nb * 64, nullptr, (bf16_t*)(ws + WS_WOUT) + (size_t)l * DM * DMIX, DMIX, kb * 64, nb * 64, T, tid); continue; }
        r -= T_OUT;
        { const int kb = r / 16, nb = r % 16;
            transpose_tile(P.in[15] + (size_t)l * DM * DM, DM, nb * 64, P.in[14] + l * DM, (bf16_t*)(ws + WS_WKV) + (size_t)l * DM * DM, DM, kb * 64, nb * 64, T, tid); }
    }
    const int gt = bid * NTHR + tid, NG = G * NTHR;
    {
        const int* pos = (const int*)P.in[2];
        float* C = (float*)(ws + WS_COS); float* Sn = (float*)(ws + WS_SIN);
        for (int i = gt; i < 32768 * 8; i += NG) { const int row = i >> 3, j = i & 7; const float ang = (float)pos[row] * P.inv_freq[j]; C[i] = cosf(ang); Sn[i] = sinf(ang); }
    }
    { float* LB = (float*)(ws + WS_LB); const float* lg = P.in[6];
      for (int i = gt; i < 512; i += NG) { LB[i] = 0.f; LB[512 + i] = 1.f / (1.f + expf(lg[i] - lg[512 + i])); } }
    { const int lane = tid & 63, gw = (bid * NTHR + tid) >> 6, NGW = (G * NTHR) >> 6;
      for (int r = gw; r < 512; r += NGW) {
          const f32x4* xr = (const f32x4*)(P.in[1] + (size_t)r * DM) + lane; f32x4 v[4]; float s = 0.f;
#pragma unroll
          for (int j = 0; j < 4; ++j) { v[j] = xr[64 * j]; s += v[j].x * v[j].x + v[j].y * v[j].y + v[j].z * v[j].z + v[j].w * v[j].w; }
          const float rs = rsqrtf(wave_sum(s) * (1.f / DM) + EPS);
          u32x2* o = (u32x2*)((bf16_t*)(ws + WS_MNB) + (size_t)r * DM) + lane;
#pragma unroll
          for (int j = 0; j < 4; ++j) { u32x2 w; w.x = pk2(v[j].x * rs, v[j].y * rs); w.y = pk2(v[j].z * rs, v[j].w * rs); o[64 * j] = w; }
      } }
}

DI void prep_rows(const Params& P, const float* xsrc, int layer) {
    const int tid = opaque((int)threadIdx.x), lane = tid & 63, gw = (blockIdx.x * NTHR + tid) >> 6, NGW = (gridDim.x * NTHR) >> 6;
    unsigned char* ws = P.ws;
    const float* win = P.in[4] + (size_t)layer * DM * NINO; const float* ng = P.in[3] + layer * DM; const float* gb = P.in[5] + layer * 8;
    bf16_t* XB = (bf16_t*)(ws + WS_XB); float* RSTD = (float*)(ws + WS_RSTD); float* GATES = (float*)(ws + WS_GATES);
    for (int r = gw; r < MP; r += NGW) {
        const f32x4* xr = (const f32x4*)(xsrc + (size_t)r * DM) + lane; f32x4 v[4]; float s = 0.f;
#pragma unroll
        for (int j = 0; j < 4; ++j) { v[j] = xr[64 * j]; s += v[j].x * v[j].x + v[j].y * v[j].y + v[j].z * v[j].z + v[j].w * v[j].w; }
        const float rs = rsqrtf(wave_sum(s) * (1.f / DM) + EPS);
        u32x2* o = (u32x2*)(XB + (size_t)r * DM) + lane;
#pragma unroll
        for (int j = 0; j < 4; ++j) { u32x2 w; w.x = pk2(v[j].x, v[j].y); w.y = pk2(v[j].z, v[j].w); o[64 * j] = w; }
        float d[8];
#pragma unroll
        for (int g = 0; g < 8; ++g) d[g] = 0.f;
#pragma unroll
        for (int j = 0; j < 4; ++j) {
#pragma unroll
            for (int e = 0; e < 4; ++e) { const int k = 4 * lane + 256 * j + e; const float xv = v[j][e] * ng[k];
                const f32x4 w0 = *(const f32x4*)(win + (size_t)k * NINO + 6144); const f32x4 w1 = *(const f32x4*)(win + (size_t)k * NINO + 6148);
                d[0] += xv * w0.x; d[1] += xv * w0.y; d[2] += xv * w0.z; d[3] += xv * w0.w; d[4] += xv * w1.x; d[5] += xv * w1.y; d[6] += xv * w1.z; d[7] += xv * w1.w; }
        }
#pragma unroll
        for (int g = 0; g < 8; ++g) d[g] = wave_sum(d[g]) * rs;
        if (lane == 0) {
            RSTD[r] = rs;
            f32x4 gi, gf;
#pragma unroll
            for (int g = 0; g < 4; ++g) { gi[g] = d[g] + gb[g]; const float z = d[4 + g] + gb[4 + g]; gf[g] = fminf(z, 0.f) - log1pf(expf(-fabsf(z))); }
            *(f32x4*)(GATES + (size_t)r * 8) = gi; *(f32x4*)(GATES + (size_t)r * 8 + 4) = gf;
        }
    }
}

DI void gemm_tile(const bf16_t* A, int lda, const bf16_t* Bt, int ldb, int K, int row0, int col0, unsigned char* lds) {
    const int tid = opaque((int)threadIdx.x), lane = tid & 63, w = __builtin_amdgcn_readfirstlane(tid >> 6), wr = w >> 2, wc = w & 3, fr = lane & 15, fq = lane >> 4;
    f32x4 acc[4][2];
#pragma unroll
    for (int m = 0; m < 4; ++m)
#pragma unroll
        for (int n = 0; n < 2; ++n) acc[m][n] = (f32x4){0.f, 0.f, 0.f, 0.f};
    u32x4 ra[2], rb[2];
    const int nt = K / 64;
    int sr[2], sc[2], so[2];
#pragma unroll
    for (int i = 0; i < 2; ++i) { const int c = tid + NTHR * i; sr[i] = c >> 3; sc[i] = c & 7; so[i] = sr[i] * 128 + ((sc[i] ^ (sr[i] & 7)) << 4); }
#pragma unroll
    for (int i = 0; i < 2; ++i) { ra[i] = *(const u32x4*)(A + (size_t)(row0 + sr[i]) * lda + sc[i] * 8); rb[i] = *(const u32x4*)(Bt + (size_t)(col0 + sr[i]) * ldb + sc[i] * 8); }
#pragma unroll
    for (int i = 0; i < 2; ++i) { *(u32x4*)(lds + so[i]) = ra[i]; *(u32x4*)(lds + 16384 + so[i]) = rb[i]; }
    __syncthreads();
    for (int t = 0; t < nt; ++t) {
        const unsigned char* LA = lds + (t & 1) * 32768; const unsigned char* LB = LA + 16384;
        if (t + 1 < nt) {
#pragma unroll
            for (int i = 0; i < 2; ++i) { ra[i] = *(const u32x4*)(A + (size_t)(row0 + sr[i]) * lda + (t + 1) * 64 + sc[i] * 8); rb[i] = *(const u32x4*)(Bt + (size_t)(col0 + sr[i]) * ldb + (t + 1) * 64 + sc[i] * 8); }
        }
#pragma unroll
        for (int kk = 0; kk < 2; ++kk) {
            bf16x8 af[4], bfr[2]; const int ch = kk * 4 + fq;
#pragma unroll
            for (int m = 0; m < 4; ++m) { const int r = wr * 64 + m * 16 + fr; af[m] = *(const bf16x8*)(LA + r * 128 + ((ch ^ (r & 7)) << 4)); }
#pragma unroll
            for (int n = 0; n < 2; ++n) { const int r = wc * 32 + n * 16 + fr; bfr[n] = *(const bf16x8*)(LB + r * 128 + ((ch ^ (r & 7)) << 4)); }
#pragma unroll
            for (int m = 0; m < 4; ++m)
#pragma unroll
                for (int n = 0; n < 2; ++n) acc[m][n] = mfma16(af[m], bfr[n], acc[m][n]);
        }
        if (t + 1 < nt) {
            unsigned char* NA = lds + ((t + 1) & 1) * 32768;
#pragma unroll
            for (int i = 0; i < 2; ++i) { *(u32x4*)(NA + so[i]) = ra[i]; *(u32x4*)(NA + 16384 + so[i]) = rb[i]; }
        }
        __syncthreads();
    }
    float* T = (float*)lds;
#pragma unroll
    for (int m = 0; m < 4; ++m)
#pragma unroll
        for (int n = 0; n < 2; ++n)
#pragma unroll
            for (int r = 0; r < 4; ++r) T[(wr * 64 + m * 16 + 4 * fq + r) * 132 + wc * 32 + n * 16 + fr] = acc[m][n][r];
    __syncthreads();
}

DI void epi_inproj(const Params& P, const float* T, int row0, int col0, int layer, int batch) {
    const int tid = opaque((int)threadIdx.x); unsigned char* ws = P.ws;
    const int seg = col0 >> 9, cseg = col0 & 511;
    const float* RSTD = (const float*)(ws + WS_RSTD);
    const bool transposed = (seg == 2 || seg == 6 || seg == 10);
    if (transposed) {
        bf16_t* dst = (bf16_t*)(ws + (seg == 2 ? WS_VAT : (seg == 6 ? WS_VBT : WS_CVT)));
#pragma unroll
        for (int j = 0; j < 4; ++j) { const int item = tid + NTHR * j, rc = item & 15, col = item >> 4; float f[8];
#pragma unroll
            for (int i = 0; i < 8; ++i) f[i] = T[(rc * 8 + i) * 132 + col] * RSTD[row0 + rc * 8 + i];
            *(u32x4*)(dst + (size_t)(cseg + col) * MP + row0 + rc * 8) = pack8(f); }
        return;
    }
    const float* LB = (const float*)(ws + WS_LB) + layer * 512;
    const float* COSt = (const float*)(ws + WS_COS); const float* SINt = (const float*)(ws + WS_SIN);
#pragma unroll
    for (int j = 0; j < 4; ++j) {
        const int item = tid + NTHR * j, r = item >> 4, ch = item & 15, row = row0 + r, c = cseg + ch * 8;
        const float rs = RSTD[row]; float v[8];
        { const f32x4 a = *(const f32x4*)(T + r * 132 + ch * 8), b = *(const f32x4*)(T + r * 132 + ch * 8 + 4);
          v[0] = a.x * rs; v[1] = a.y * rs; v[2] = a.z * rs; v[3] = a.w * rs; v[4] = b.x * rs; v[5] = b.y * rs; v[6] = b.z * rs; v[7] = b.w * rs; }
        bf16_t* dst = nullptr; size_t doff = (size_t)row * 512 + c;
        switch (seg) {
        case 0: { dst = (bf16_t*)(ws + WS_QA);
#pragma unroll
            for (int i = 0; i < 8; ++i) v[i] = siluf_(v[i]) * 0.08838834764831845f; } break;
        case 1: { dst = (bf16_t*)(ws + WS_LF);
#pragma unroll
            for (int i = 0; i < 8; ++i) { const float lb = LB[c + i]; v[i] = logf(fmaxf(lb + (1.f - lb) * sigmoidf_(v[i]), 1e-30f)); } } break;
        case 3: case 7: case 12: case 14: { dst = (bf16_t*)(ws + WS_Y); doff = (size_t)row * DMIX + (seg == 3 ? 0 : (seg == 7 ? 512 : (seg == 12 ? 1024 : 1536))) + c;
#pragma unroll
            for (int i = 0; i < 8; ++i) v[i] = siluf_(v[i]); } break;
        case 4: case 5: {
            dst = (bf16_t*)(ws + (seg == 4 ? WS_QB : WS_KB));
            float ss = 0.f;
#pragma unroll
            for (int i = 0; i < 8; ++i) ss += v[i] * v[i];
            ss += __shfl_xor(ss, 1); ss += __shfl_xor(ss, 2); ss += __shfl_xor(ss, 4);
            const float rn = rsqrtf(ss * (1.f / 64.f) + EPS);
            const float* g = P.in[8] + layer * 128 + (seg == 4 ? 0 : 64) + (ch & 7) * 8;
            const int grow = batch * SEQ + row; const int c7 = ch & 7;
            const float sc = (seg == 4) ? 0.125f : 1.f;
#pragma unroll
            for (int i = 0; i < 8; ++i) {
                float y = v[i] * rn * g[i];
                const float part = __shfl_xor(y, 1);
                const float cs = COSt[grow * 8 + i], sn = SINt[grow * 8 + i];
                if (c7 == 0) y = y * cs - part * sn; else if (c7 == 1) y = y * cs + part * sn;
                v[i] = y * sc;
            } } break;
        case 8: dst = (bf16_t*)(ws + WS_CQ); break;
        case 9: dst = (bf16_t*)(ws + WS_CK); break;
        case 11: { dst = (bf16_t*)(ws + WS_OG);
#pragma unroll
            for (int i = 0; i < 8; ++i) v[i] = sigmoidf_(v[i]); } break;
        case 13: { dst = (bf16_t*)(ws + WS_QX);
            float ss = 0.f;
#pragma unroll
            for (int i = 0; i < 8; ++i) ss += v[i] * v[i];
            ss += __shfl_xor(ss, 1); ss += __shfl_xor(ss, 2); ss += __shfl_xor(ss, 4); ss += __shfl_xor(ss, 8);
            const float rn = rsqrtf(ss * (1.f / 128.f) + EPS) * 0.08838834764831845f;
            const float* g = P.in[16] + layer * 256 + ch * 8;
#pragma unroll
            for (int i = 0; i < 8; ++i) v[i] = v[i] * rn * g[i]; } break;
        default: break;
        }
        *(u32x4*)(dst + doff) = pack8(v);
    }
}

DI void epi_kvmem(const Params& P, const float* T, int row0, int col0, int layer) {
    const int tid = opaque((int)threadIdx.x); unsigned char* ws = P.ws;
    if (col0 < 512) {
        bf16_t* dst = (bf16_t*)(ws + WS_KMB) + (size_t)layer * 512 * 512;
        const float* g = P.in[16] + layer * 256 + 128;
#pragma unroll
        for (int j = 0; j < 4; ++j) { const int item = tid + NTHR * j, r = item >> 4, ch = item & 15; float v[8];
            { const f32x4 a = *(const f32x4*)(T + r * 132 + ch * 8), b = *(const f32x4*)(T + r * 132 + ch * 8 + 4);
              v[0] = a.x; v[1] = a.y; v[2] = a.z; v[3] = a.w; v[4] = b.x; v[5] = b.y; v[6] = b.z; v[7] = b.w; }
            float ss = 0.f;
#pragma unroll
            for (int i = 0; i < 8; ++i) ss += v[i] * v[i];
            ss += __shfl_xor(ss, 1); ss += __shfl_xor(ss, 2); ss += __shfl_xor(ss, 4); ss += __shfl_xor(ss, 8);
            const float rn = rsqrtf(ss * (1.f / 128.f) + EPS);
#pragma unroll
            for (int i = 0; i < 8; ++i) v[i] = v[i] * rn * g[ch * 8 + i];
            *(u32x4*)(dst + (size_t)(row0 + r) * 512 + col0 + ch * 8) = pack8(v); }
    } else {
        const int b = row0 >> 8, m0 = row0 & 255;
        bf16_t* dst = (bf16_t*)(ws + WS_VMT) + (size_t)(layer * 2 + b) * 512 * 256;
#pragma unroll
        for (int j = 0; j < 4; ++j) { const int item = tid + NTHR * j, rc = item & 15, col = item >> 4; float f[8];
#pragma unroll
            for (int i = 0; i < 8; ++i) f[i] = T[(rc * 8 + i) * 132 + col];
            *(u32x4*)(dst + (size_t)(col0 - 512 + col) * 256 + m0 + rc * 8) = pack8(f); }
    }
}

DI void epi_outproj(const float* T, const float* xold, float* out, int grow0, int col0) {
    const int tid = opaque((int)threadIdx.x);
#pragma unroll
    for (int j = 0; j < 8; ++j) { const int item = tid + NTHR * j, r = item >> 5, c4 = item & 31;
        const size_t off = (size_t)(grow0 + r) * DM + col0 + c4 * 4;
        const f32x4 a = *(const f32x4*)(T + r * 132 + c4 * 4), x = *(const f32x4*)(xold + off);
        *(f32x4*)(out + off) = a + x; }
}

template <int NCOMP>
DI void attn_unit(const Params& P, unsigned char* lds, int layer, int batch, int h, int qb) {
    constexpr int NS = (NCOMP == 2) ? 4 : 8;
    constexpr int STG = 64 * 272 + 128 * 136;
    const int tid = opaque((int)threadIdx.x), lane = tid & 63, w = __builtin_amdgcn_readfirstlane(tid >> 6), l31 = lane & 31, h2 = lane >> 5;
    unsigned char* ws = P.ws;
    const int comp = (NCOMP == 2) ? (w >> 2) : 0;
    const int q0 = (NCOMP == 2) ? qb * 128 : qb * 256;
    const int qw = (NCOMP == 2) ? q0 + 32 * (w & 3) : q0 + 32 * w;
    const bf16_t* Qsrc = (const bf16_t*)(ws + (NCOMP == 2 ? WS_QB : WS_QX));
    const bf16_t* Ksrc; const bf16_t* Vsrc; int ldv, nkt;
    if (NCOMP == 2) { Ksrc = (const bf16_t*)(ws + WS_KB) + h * 128; Vsrc = (const bf16_t*)(ws + WS_VBT) + (size_t)(h * 128) * MP; ldv = MP; nkt = 2 * qb + 2; }
    else { Ksrc = (const bf16_t*)(ws + WS_KMB) + (size_t)layer * 512 * 512 + (size_t)batch * 256 * 512 + h * 128;
           Vsrc = (const bf16_t*)(ws + WS_VMT) + (size_t)(layer * 2 + batch) * 512 * 256 + (size_t)(h * 128) * 256; ldv = 256; nkt = 4; }
    bf16x8 qf[NS];
    { const bf16_t* qp = Qsrc + (size_t)(qw + l31) * 512 + h * 128 + comp * 64 + 8 * h2;
#pragma unroll
      for (int s = 0; s < NS; ++s) qf[s] = *(const bf16x8*)(qp + 16 * s); }
    f32x16 O[4];
#pragma unroll
    for (int d = 0; d < 4; ++d)
#pragma unroll
        for (int i = 0; i < 16; ++i) O[d][i] = 0.f;
    float mrun = -1e30f, lsum = 0.f;
    u32x4 rk[2], rv[2]; int kr[2], kc[2], vr[2], vc[2];
#pragma unroll
    for (int i = 0; i < 2; ++i) { const int c = tid + NTHR * i; kr[i] = c >> 4; kc[i] = c & 15; vr[i] = c >> 3; vc[i] = c & 7; }
#pragma unroll
    for (int i = 0; i < 2; ++i) { rk[i] = *(const u32x4*)(Ksrc + (size_t)kr[i] * 512 + kc[i] * 8); rv[i] = *(const u32x4*)(Vsrc + (size_t)vr[i] * ldv + vc[i] * 8); }
#pragma unroll
    for (int i = 0; i < 2; ++i) { *(u32x4*)(lds + kr[i] * 272 + kc[i] * 16) = rk[i];
        unsigned char* vp = lds + 64 * 272 + vr[i] * 136 + vc[i] * 16; *(u32x2*)vp = (u32x2){rv[i].x, rv[i].y}; *(u32x2*)(vp + 8) = (u32x2){rv[i].z, rv[i].w}; }
    __syncthreads();
    for (int kt = 0; kt < nkt; ++kt) {
        const unsigned char* LK = lds + (kt & 1) * STG; const unsigned char* LV = LK + 64 * 272;
        if (kt + 1 < nkt) {
#pragma unroll
            for (int i = 0; i < 2; ++i) { rk[i] = *(const u32x4*)(Ksrc + (size_t)((kt + 1) * 64 + kr[i]) * 512 + kc[i] * 8); rv[i] = *(const u32x4*)(Vsrc + (size_t)vr[i] * ldv + (kt + 1) * 64 + vc[i] * 8); }
        }
        const bool active = (NCOMP == 1) || (kt * 64 <= qw + 31);
        if (active) {
#pragma unroll
            for (int kb = 0; kb < 2; ++kb) {
                f32x16 S;
#pragma unroll
                for (int i = 0; i < 16; ++i) S[i] = 0.f;
#pragma unroll
                for (int s = 0; s < NS; ++s) { const bf16x8 kf = *(const bf16x8*)(LK + (32 * kb + l31) * 272 + comp * 128 + (16 * s + 8 * h2) * 2); S = mfma32(kf, qf[s], S); }
                if (NCOMP == 2 && (kt * 64 + 32 * kb + 31 > qw)) {
                    const int qpos = qw + l31;
#pragma unroll
                    for (int i = 0; i < 16; ++i) { const int key = kt * 64 + 32 * kb + crow(i, h2); if (key > qpos) S[i] = -1e30f; }
                }
                float mx = S[0];
#pragma unroll
                for (int i = 1; i < 16; ++i) mx = fmaxf(mx, S[i]);
                mx = fmaxf(mx, __shfl_xor(mx, 32));
                const float mnew = fmaxf(mrun, mx), alpha = __expf(mrun - mnew);
                mrun = mnew;
                float ps = 0.f;
#pragma unroll
                for (int i = 0; i < 16; ++i) { const float p = __expf(S[i] - mnew); S[i] = p; ps += p; }
                lsum = lsum * alpha + ps;
#pragma unroll
                for (int d = 0; d < 4; ++d)
#pragma unroll
                    for (int i = 0; i < 16; ++i) O[d][i] *= alpha;
#pragma unroll
                for (int s2 = 0; s2 < 2; ++s2) {
                    u32x4 pp; pp.x = pk2(S[8 * s2 + 0], S[8 * s2 + 1]); pp.y = pk2(S[8 * s2 + 2], S[8 * s2 + 3]); pp.z = pk2(S[8 * s2 + 4], S[8 * s2 + 5]); pp.w = pk2(S[8 * s2 + 6], S[8 * s2 + 7]);
                    const bf16x8 pf = __builtin_bit_cast(bf16x8, pp);
#pragma unroll
                    for (int d = 0; d < 4; ++d) {
                        const unsigned char* vp = LV + (32 * d + l31) * 136 + (32 * kb + 16 * s2 + 4 * h2) * 2;
                        const s16x4 lo = *(const s16x4*)vp, hi = *(const s16x4*)(vp + 16);
                        const bf16x8 vf = __builtin_shufflevector(lo, hi, 0, 1, 2, 3, 4, 5, 6, 7);
                        O[d] = mfma32(vf, pf, O[d]);
                    }
                }
            }
        }
        if (kt + 1 < nkt) {
            unsigned char* NK = lds + ((kt + 1) & 1) * STG;
#pragma unroll
            for (int i = 0; i < 2; ++i) { *(u32x4*)(NK + kr[i] * 272 + kc[i] * 16) = rk[i];
                unsigned char* vp = NK + 64 * 272 + vr[i] * 136 + vc[i] * 16; *(u32x2*)vp = (u32x2){rv[i].x, rv[i].y}; *(u32x2*)(vp + 8) = (u32x2){rv[i].z, rv[i].w}; }
        }
        __syncthreads();
    }
    const float inv = 1.f / (lsum + __shfl_xor(lsum, 32));
#pragma unroll
    for (int d = 0; d < 4; ++d)
#pragma unroll
        for (int i = 0; i < 16; ++i) O[d][i] *= inv;
    bf16_t* Y = (bf16_t*)(ws + WS_Y);
    if (NCOMP == 1) {
        bf16_t* yp = Y + (size_t)(qw + l31) * DMIX + 1536 + h * 128;
#pragma unroll
        for (int d = 0; d < 4; ++d)
#pragma unroll
            for (int g = 0; g < 4; ++g) { const int dv = 32 * d + 8 * g + 4 * h2; const u32x2 gt = *(const u32x2*)(yp + dv);
                u32x2 o; o.x = pk2(O[d][4 * g + 0] * __uint_as_float(gt.x << 16), O[d][4 * g + 1] * __uint_as_float(gt.x & 0xffff0000u));
                o.y = pk2(O[d][4 * g + 2] * __uint_as_float(gt.y << 16), O[d][4 * g + 3] * __uint_as_float(gt.y & 0xffff0000u));
                *(u32x2*)(yp + dv) = o; }
        __syncthreads();
        return;
    }
    float* X = (float*)lds;
    const int ql = 32 * (w & 3) + l31;
    if (comp == 1) {
#pragma unroll
        for (int d = 0; d < 4; ++d)
#pragma unroll
            for (int i = 0; i < 16; ++i) X[ql * 132 + 32 * d + crow(i, h2)] = O[d][i];
    }
    __syncthreads();
    const float* lp = P.in[9] + layer * 256;
    float lam;
    { const float a = wave_sum(lp[lane] * lp[64 + lane]), b = wave_sum(lp[128 + lane] * lp[192 + lane]);
      const float lam_init = 0.8f - 0.6f * expf(-0.3f * (float)layer); lam = expf(a) - expf(b) + lam_init; }
    if (comp == 0) {
#pragma unroll
        for (int d = 0; d < 4; ++d)
#pragma unroll
            for (int i = 0; i < 16; ++i) { const int a = ql * 132 + 32 * d + crow(i, h2); X[a] = O[d][i] - lam * X[a]; }
    }
    __syncthreads();
    {
        const float lam_init = 0.8f - 0.6f * expf(-0.3f * (float)layer);
        const float* g = P.in[10] + layer * 128;
#pragma unroll
        for (int j = 0; j < 4; ++j) { const int item = tid + NTHR * j, r = item >> 4, ch = item & 15; float v[8];
            { const f32x4 a = *(const f32x4*)(X + r * 132 + ch * 8), b = *(const f32x4*)(X + r * 132 + ch * 8 + 4);
              v[0] = a.x; v[1] = a.y; v[2] = a.z; v[3] = a.w; v[4] = b.x; v[5] = b.y; v[6] = b.z; v[7] = b.w; }
            float ss = 0.f;
#pragma unroll
            for (int i = 0; i < 8; ++i) ss += v[i] * v[i];
            ss += __shfl_xor(ss, 1); ss += __shfl_xor(ss, 2); ss += __shfl_xor(ss, 4); ss += __shfl_xor(ss, 8);
            const float rn = rsqrtf(ss * (1.f / 128.f) + EPS) * (1.f - lam_init);
            bf16_t* yp = Y + (size_t)(q0 + r) * DMIX + 512 + h * 128 + ch * 8; float gt[8]; unpack8(*(const u32x4*)yp, gt);
#pragma unroll
            for (int i = 0; i < 8; ++i) v[i] = v[i] * rn * g[ch * 8 + i] * gt[i];
            *(u32x4*)yp = pack8(v); }
    }
    __syncthreads();
}

constexpr int CH_QT = 0, CH_KT = 17408, CH_QH = 34816, CH_KHT = 52224, CH_VT = 70656, CH_AM = 89088, CH_OB = 98304, CH_PART = 132096,
              CH_DEC = 134144, CH_NV = 134656  , CH_SC = 135680  ;
template <int MODE  >
DI void chain_unit(const Params& P, unsigned char* lds, int layer, int batch, int h) {
    const int tid = opaque((int)threadIdx.x), lane = tid & 63, w = __builtin_amdgcn_readfirstlane(tid >> 6), fr = lane & 15, fq = lane >> 4;
    const int k = tid & 127, tg = w >> 1;
    unsigned char* ws = P.ws;
    bf16_t* QT = (bf16_t*)(lds + CH_QT); bf16_t* KT = (bf16_t*)(lds + CH_KT); bf16_t* QH = (bf16_t*)(lds + CH_QH);
    float* OB = (float*)(lds + CH_OB); float* PART = (float*)(lds + CH_PART); float* DEC = (float*)(lds + CH_DEC);
    float* NV = (float*)(lds + CH_NV); float* SCA = (float*)(lds + CH_SC); float* SCM = SCA + 64; float* SCWI = SCA + 128; float* SCE = SCA + 192;
    const bf16_t* Vsrc = (const bf16_t*)(ws + (MODE == 0 ? WS_VAT : WS_CVT)) + (size_t)(h * 128) * MP;
    bf16_t* Y = (bf16_t*)(ws + WS_Y);
    f32x4 Sacc[8];
#pragma unroll
    for (int i = 0; i < 8; ++i) Sacc[i] = (f32x4){0.f, 0.f, 0.f, 0.f};
    float mcar = 0.f;
    if (MODE == 1) { if (tid < 256) NV[tid] = 0.f; }
    float wq[4], wk[4], bq = 0.f, bk = 0.f;
    if (MODE == 1) { const float* cw = P.in[11] + layer * 4096; const float* cb = P.in[12] + layer * 1024;
#pragma unroll
        for (int j = 0; j < 4; ++j) { wq[j] = cw[j * 1024 + h * 128 + k]; wk[j] = cw[j * 1024 + 512 + h * 128 + k]; }
        bq = cb[h * 128 + k]; bk = cb[512 + h * 128 + k]; }
    __syncthreads();
    for (int chunk = 0; chunk < SEQ / 64; ++chunk) {
        const int t0 = chunk * 64;
#pragma unroll
        for (int i = 0; i < 2; ++i) { const int c = tid + NTHR * i, dv = c >> 3, ch = c & 7;
            *(u32x4*)(lds + CH_VT + dv * 144 + ch * 16) = *(const u32x4*)(Vsrc + (size_t)dv * MP + t0 + ch * 8); }
        float khv[16];
        if (MODE == 0) {
            const bf16_t* LFp = (const bf16_t*)(ws + WS_LF) + (size_t)(t0 + 16 * tg) * 512 + h * 128 + k;
            const bf16_t* QAp = (const bf16_t*)(ws + WS_QA) + (size_t)(t0 + 16 * tg) * 512 + h * 128 + k;
            float lf[16], q[16]; float part = 0.f;
#pragma unroll
            for (int i = 0; i < 16; ++i) { lf[i] = bf2f(LFp[(size_t)i * 512]); q[i] = bf2f(QAp[(size_t)i * 512]); part += lf[i]; }
            PART[tg * 128 + k] = part;
            __syncthreads();
            const float p0 = PART[k], p1 = PART[128 + k], p2 = PART[256 + k], p3 = PART[384 + k];
            const float bmid = p0 + p1, total = bmid + p2 + p3;
            float run = (tg > 0 ? p0 : 0.f) + (tg > 1 ? p1 : 0.f) + (tg > 2 ? p2 : 0.f);
#pragma unroll
            for (int i = 0; i < 16; ++i) { run += lf[i]; const float f = __expf(lf[i]), kk = 1.f - f; const int t = 16 * tg + i;
                QT[t * 136 + k] = f2bf(q[i] * __expf(run - bmid)); KT[t * 136 + k] = f2bf(kk * __expf(bmid - run));
                QH[t * 136 + k] = f2bf(q[i] * __expf(run)); khv[i] = kk * __expf(total - run); }
            if (tg == 0) DEC[k] = __expf(total);
        } else {
            const float* GT = (const float*)(ws + WS_GATES) + (size_t)(t0 + lane) * 8;
            const float li = GT[h], lfg = GT[4 + h];
            float b = lfg;
#pragma unroll
            for (int o = 1; o < 64; o <<= 1) { const float x = __shfl_up(b, o); if (lane >= o) b += x; }
            const float a = li - b; float pm = a;
#pragma unroll
            for (int o = 1; o < 64; o <<= 1) { const float x = __shfl_up(pm, o); if (lane >= o) pm = fmaxf(pm, x); }
            const float M = fmaxf(pm, mcar), wi = __expf(mcar - M);
            const float M63 = __shfl(M, 63), bl = __shfl(b, 63);
            const float wg = __expf(a - M63), dec = __expf(mcar - M63);
            if (w == 0) { SCA[lane] = a; SCM[lane] = M; SCWI[lane] = wi; SCE[lane] = __expf(-(b + M)); }
            mcar = bl + M63;
            if (tg == 0) DEC[k] = dec;
            const bf16_t* CQp = (const bf16_t*)(ws + WS_CQ) + h * 128 + k; const bf16_t* CKp = (const bf16_t*)(ws + WS_CK) + h * 128 + k;
            float rq[19], rkk[19];
#pragma unroll
            for (int i = 0; i < 19; ++i) { const int t = t0 + 16 * tg - 3 + i; if (t >= 0) { rq[i] = bf2f(CQp[(size_t)t * 512]); rkk[i] = bf2f(CKp[(size_t)t * 512]); } else { rq[i] = 0.f; rkk[i] = 0.f; } }
#pragma unroll
            for (int i = 0; i < 16; ++i) {
                const float qv = siluf_(bq + wq[0] * rq[i] + wq[1] * rq[i + 1] + wq[2] * rq[i + 2] + wq[3] * rq[i + 3]);
                const float kv = siluf_(bk + wk[0] * rkk[i] + wk[1] * rkk[i + 1] + wk[2] * rkk[i + 2] + wk[3] * rkk[i + 3]) * 0.08838834764831845f;
                const int t = 16 * tg + i; const float wit = __shfl(wi, t), wgt = __shfl(wg, t);
                QT[t * 136 + k] = f2bf(qv); KT[t * 136 + k] = f2bf(kv); QH[t * 136 + k] = f2bf(qv * wit); khv[i] = kv * wgt; }
        }
        { unsigned char* kp = lds + CH_KHT + k * 144 + tg * 32; *(u32x4*)kp = pack8(khv); *(u32x4*)(kp + 16) = pack8(khv + 8); }
        __syncthreads();
        {
            const int mb = w >> 1;
#pragma unroll
            for (int nn = 0; nn < 2; ++nn) { const int nb = (w & 1) * 2 + nn; f32x4 acc = (f32x4){0.f, 0.f, 0.f, 0.f};
                if (nb <= mb) {
#pragma unroll
                    for (int ks = 0; ks < 4; ++ks) { const bf16x8 af = *(const bf16x8*)(lds + CH_QT + (16 * mb + fr) * 272 + (32 * ks + 8 * fq) * 2);
                        const bf16x8 bfv = *(const bf16x8*)(lds + CH_KT + (16 * nb + fr) * 272 + (32 * ks + 8 * fq) * 2); acc = mfma16(af, bfv, acc); }
                }
                const int s = 16 * nb + fr; float as = 0.f; if (MODE == 1) as = SCA[s];
#pragma unroll
                for (int r = 0; r < 4; ++r) { const int t = 16 * mb + 4 * fq + r; float v = 0.f;
                    if (s <= t) { v = acc[r]; if (MODE == 1) v *= __expf(as - SCM[t]); }
                    ((bf16_t*)(lds + CH_AM))[t * 72 + s] = f2bf(v); }
            }
        }
        if (MODE == 1 && tid < 128) { float sum = 0.f;
#pragma unroll
            for (int c8 = 0; c8 < 8; ++c8) { float f[8]; unpack8(*(const u32x4*)(lds + CH_KHT + tid * 144 + c8 * 16), f);
#pragma unroll
                for (int i = 0; i < 8; ++i) sum += f[i]; }
            NV[((chunk + 1) & 1) * 128 + tid] = DEC[tid] * NV[(chunk & 1) * 128 + tid] + sum; }
        __syncthreads();
        {
            bf16x8 vf[2];
#pragma unroll
            for (int ks = 0; ks < 2; ++ks) vf[ks] = *(const bf16x8*)(lds + CH_VT + (16 * w + fr) * 144 + (32 * ks + 8 * fq) * 2);
            bf16x8 sb[4];
#pragma unroll
            for (int ks = 0; ks < 4; ++ks) { u32x4 pp; pp.x = pk2(Sacc[2 * ks][0], Sacc[2 * ks][1]); pp.y = pk2(Sacc[2 * ks][2], Sacc[2 * ks][3]);
                pp.z = pk2(Sacc[2 * ks + 1][0], Sacc[2 * ks + 1][1]); pp.w = pk2(Sacc[2 * ks + 1][2], Sacc[2 * ks + 1][3]); sb[ks] = __builtin_bit_cast(bf16x8, pp); }
#pragma unroll
            for (int mb = 0; mb < 4; ++mb) { f32x4 o = (f32x4){0.f, 0.f, 0.f, 0.f};
#pragma unroll
                for (int ks = 0; ks < 2; ++ks) { const bf16x8 af = *(const bf16x8*)(lds + CH_AM + (16 * mb + fr) * 144 + (32 * ks + 8 * fq) * 2); o = mfma16(af, vf[ks], o); }
#pragma unroll
                for (int ks = 0; ks < 4; ++ks) { const unsigned char* qp = lds + CH_QH + (16 * mb + fr) * 272 + (32 * ks + 4 * fq) * 2;
                    const s16x4 lo = *(const s16x4*)qp, hi = *(const s16x4*)(qp + 32); const bf16x8 af = __builtin_shufflevector(lo, hi, 0, 1, 2, 3, 4, 5, 6, 7); o = mfma16(af, sb[ks], o); }
#pragma unroll
                for (int r = 0; r < 4; ++r) OB[(16 * mb + 4 * fq + r) * 132 + 16 * w + fr] = o[r];
            }
#pragma unroll
            for (int mb = 0; mb < 8; ++mb) { const f32x4 d = *(const f32x4*)(DEC + 16 * mb + 4 * fq); Sacc[mb] = Sacc[mb] * d;
#pragma unroll
                for (int ks = 0; ks < 2; ++ks) { const bf16x8 af = *(const bf16x8*)(lds + CH_KHT + (16 * mb + fr) * 144 + (32 * ks + 8 * fq) * 2); Sacc[mb] = mfma16(af, vf[ks], Sacc[mb]); } }
        }
        __syncthreads();
        {
            const int t = tid >> 3, dc = tid & 7; float o[16];
#pragma unroll
            for (int i = 0; i < 4; ++i) { const f32x4 x = *(const f32x4*)(OB + t * 132 + 16 * dc + 4 * i); o[4 * i] = x.x; o[4 * i + 1] = x.y; o[4 * i + 2] = x.z; o[4 * i + 3] = x.w; }
            const size_t row = (size_t)(t0 + t);
            if (MODE == 1) {
                float f[8]; unpack8(*(const u32x4*)(lds + CH_AM + t * 144 + dc * 16), f);
                float rsum = 0.f;
#pragma unroll
                for (int i = 0; i < 8; ++i) rsum += f[i];
                float qn = 0.f; const float* nv = NV + (chunk & 1) * 128 + 16 * dc;
                float qf8[8]; unpack8(*(const u32x4*)(lds + CH_QT + t * 272 + dc * 32), qf8);
#pragma unroll
                for (int i = 0; i < 8; ++i) qn += qf8[i] * nv[i];
                unpack8(*(const u32x4*)(lds + CH_QT + t * 272 + dc * 32 + 16), qf8);
#pragma unroll
                for (int i = 0; i < 8; ++i) qn += qf8[i] * nv[8 + i];
                rsum += __shfl_xor(rsum, 1); rsum += __shfl_xor(rsum, 2); rsum += __shfl_xor(rsum, 4);
                qn += __shfl_xor(qn, 1); qn += __shfl_xor(qn, 2); qn += __shfl_xor(qn, 4);
                const float nq = rsum + SCWI[t] * qn; const float den = 1.f / fmaxf(fabsf(nq), SCE[t]);
                const bf16_t* ogp = (const bf16_t*)(ws + WS_OG) + row * 512 + h * 128 + 16 * dc; float og[16];
                unpack8(*(const u32x4*)ogp, og); unpack8(*(const u32x4*)(ogp + 8), og + 8);
#pragma unroll
                for (int i = 0; i < 16; ++i) o[i] = o[i] * den * og[i];
            }
            float ss = 0.f;
#pragma unroll
            for (int i = 0; i < 16; ++i) ss += o[i] * o[i];
            ss += __shfl_xor(ss, 1); ss += __shfl_xor(ss, 2); ss += __shfl_xor(ss, 4);
            const float rn = rsqrtf(ss * (1.f / 128.f) + EPS);
            const float* g = (MODE == 0 ? P.in[7] : P.in[13]) + layer * 128 + 16 * dc;
            bf16_t* yp = Y + row * DMIX + (MODE == 0 ? 0 : 1024) + h * 128 + 16 * dc; float gt[16];
            unpack8(*(const u32x4*)yp, gt); unpack8(*(const u32x4*)(yp + 8), gt + 8);
#pragma unroll
            for (int i = 0; i < 16; ++i) o[i] = o[i] * rn * g[i] * gt[i];
            *(u32x4*)yp = pack8(o); *(u32x4*)(yp + 8) = pack8(o + 8);
        }
        __syncthreads();
    }
}

#ifdef DIS_C0
#define ENA_C0(x)
#else
#define ENA_C0(x) x
#endif
#ifdef DIS_C1
#define ENA_C1(x)
#else
#define ENA_C1(x) x
#endif
#ifdef DIS_A2
#define ENA_A2(x)
#else
#define ENA_A2(x) x
#endif
#ifdef DIS_A1
#define ENA_A1(x)
#else
#define ENA_A1(x) x
#endif
__global__ void __launch_bounds__(NTHR, 2) hymba_fwd(Params P) {
    extern __shared__ __attribute__((aligned(16))) unsigned char lds[];
    cg::grid_group grid = cg::this_grid();
    const int tid = opaque((int)threadIdx.x), bid = blockIdx.x, G = gridDim.x;
    unsigned char* ws = P.ws;
    unsigned* CTL = (unsigned*)(ws + WS_CTL);
    volatile int* s_unit = (volatile int*)(lds + LDS_UNIT_OFF);

    phase0(P, lds);
    for (int b = 0; b < NBATCH; ++b) {
        for (int l = 0; l < 2; ++l) {
            const float* xold = (l == 0 ? P.in[0] : (const float*)P.out) + (size_t)b * MP * DM;
            prep_rows(P, xold, l);
            grid.sync();
            {
                const int nt_in = (MP / 128) * (NIN / 128);
                const int nt_kv = (b == 0 && l == 0) ? 2 * 4 * 8 : 0;
                for (int tile = bid; tile < nt_in + nt_kv; tile += G) {
                    if (tile < nt_in) { const int tm = tile / (NIN / 128), tn = tile % (NIN / 128);
                        gemm_tile((const bf16_t*)(ws + WS_XB), DM, (const bf16_t*)(ws + WS_WIN) + (size_t)l * NIN * DM, DM, DM, tm * 128, tn * 128, lds);
                        epi_inproj(P, (const float*)lds, tm * 128, tn * 128, l, b);
                    } else { int r = tile - nt_in; const int ll = r / 32; r -= ll * 32; const int tm = r / 8, tn = r % 8;
                        gemm_tile((const bf16_t*)(ws + WS_MNB), DM, (const bf16_t*)(ws + WS_WKV) + (size_t)ll * DM * DM, DM, DM, tm * 128, tn * 128, lds);
                        epi_kvmem(P, (const float*)lds, tm * 128, tn * 128, ll);
                    }
                    __syncthreads();
                }
            }
            grid.sync();
            {
                unsigned* ctr = CTL + 16 * (b * 2 + l);
                for (;;) {
                    if (tid == 0) *s_unit = (int)atomicAdd(ctr, 1u);
                    __syncthreads();
                    const int u = *s_unit;
                    __syncthreads();
                    if (u >= 8 + 512 + 256) break;
                    if (u < 4) { ENA_C0(chain_unit<0>(P, lds, l, b, u)); }
                    else if (u < 8) { ENA_C1(chain_unit<1>(P, lds, l, b, u - 4)); }
                    else if (u < 8 + 512) { const int i = u - 8; ENA_A2(attn_unit<2>(P, lds, l, b, i & 3, 127 - (i >> 2))); }
                    else { const int i = u - 520; ENA_A1(attn_unit<1>(P, lds, l, b, i & 3, i >> 2)); }
                }
            }
            grid.sync();
            {
                const int nt = (MP / 128) * (DM / 128);
                for (int tile = bid; tile < nt; tile += G) { const int tm = tile / 8, tn = tile % 8;
                    gemm_tile((const bf16_t*)(ws + WS_Y), DMIX, (const bf16_t*)(ws + WS_WOUT) + (size_t)l * DM * DMIX, DMIX, DMIX, tm * 128, tn * 128, lds);
                    epi_outproj((const float*)lds, xold, P.out + (size_t)b * MP * DM, tm * 128, tn * 128);
                    __syncthreads();
                }
            }
            grid.sync();
        }
    }
}

extern "C" void kernel_launch(void* const* d_in, const int* in_sizes, int n_in, void* d_out, int out_size, void* d_ws, size_t ws_size, hipStream_t stream) {
    static int grid = 0;
    if (grid == 0) {
        if (n_in != 18 || ws_size < WS_END) { fprintf(stderr, "kernel_launch: unexpected n_in %d or ws_size %zu < %zu\n", n_in, ws_size, (size_t)WS_END); grid = -1; return; }
        int dev = 0, cus = 0, per_cu = 0;
        hipGetDevice(&dev);
        hipDeviceGetAttribute(&cus, hipDeviceAttributeMultiprocessorCount, dev);
        hipFuncSetAttribute((const void*)hymba_fwd, hipFuncAttributeMaxDynamicSharedMemorySize, LDS_BYTES);
        hipOccupancyMaxActiveBlocksPerMultiprocessor(&per_cu, (const void*)hymba_fwd, NTHR, LDS_BYTES);
        if (per_cu < 1) per_cu = 1;
        grid = cus * per_cu;
    }
    if (grid < 0) return;
    Params p{};
    for (int i = 0; i < 18; ++i) p.in[i] = (const float*)d_in[i];
    p.out = (float*)d_out; p.ws = (unsigned char*)d_ws;
    for (int j = 0; j < 8; ++j) p.inv_freq[j] = (float)pow(500000.0, -(double)(2 * j) / 16.0);
    p.mode = 0; p.pad = 0;
    void* args[] = {&p};
    hipError_t e = hipLaunchCooperativeKernel((const void*)hymba_fwd, dim3(grid), dim3(NTHR), args, LDS_BYTES, stream);
    if (e != hipSuccess) fprintf(stderr, "cooperative launch failed: %s (grid %d)\n", hipGetErrorString(e), grid);
}
```

```cpp
#include <hip/hip_runtime.h>
#include <hip/hip_cooperative_groups.h>
#include <cstdio>
#include <cstdint>
#include <cmath>
namespace cg = cooperative_groups;

#define DI __device__ __forceinline__
typedef unsigned short bf16_t;
typedef short bf16x8 __attribute__((ext_vector_type(8)));
typedef short s16x4 __attribute__((ext_vector_type(4)));
typedef float f32x2 __attribute__((ext_vector_type(2)));
typedef float f32x4 __attribute__((ext_vector_type(4)));
typedef float f32x16 __attribute__((ext_vector_type(16)));
typedef __bf16 bf16x2v __attribute__((ext_vector_type(2)));
typedef unsigned u32x2 __attribute__((ext_vector_type(2)));
typedef unsigned u32x4 __attribute__((ext_vector_type(4)));

constexpr int SEQ = 16384, DM = 1024, NBATCH = 2, MP = 16384;
constexpr int NIN = 7680, NINO = 7688, DMIX = 2048;
constexpr int NTHR = 512;
constexpr float EPS = 1e-6f;
constexpr int LDS_BYTES = 143360;
constexpr int LDS_UNIT_OFF = 143344;

constexpr size_t WS_CTL   = 0;
constexpr size_t WS_WIN   = 4096;
constexpr size_t WS_WOUT  = WS_WIN  + (size_t)2 * NIN * DM * 2;
constexpr size_t WS_WKV   = WS_WOUT + (size_t)2 * DM * DMIX * 2;
constexpr size_t WS_MNB   = WS_WKV  + (size_t)2 * DM * DM * 2;
constexpr size_t WS_KMB   = WS_MNB  + (size_t)512 * DM * 2;
constexpr size_t WS_VMT   = WS_KMB  + (size_t)2 * 512 * 512 * 2;
constexpr size_t WS_COS   = WS_VMT  + (size_t)2 * 2 * 512 * 256 * 2;
constexpr size_t WS_SIN   = WS_COS  + (size_t)32768 * 8 * 4;
constexpr size_t WS_LB    = WS_SIN  + (size_t)32768 * 8 * 4;
constexpr size_t WS_XB    = WS_LB   + 4096;
constexpr size_t WS_RSTD  = WS_XB   + (size_t)MP * DM * 2;
constexpr size_t WS_GATES = WS_RSTD + (size_t)MP * 4;
constexpr size_t SZ512    = (size_t)MP * 512 * 2;
constexpr size_t WS_QA    = WS_GATES + (size_t)MP * 8 * 4;
constexpr size_t WS_LF    = WS_QA + SZ512;
constexpr size_t WS_VAT   = WS_LF + SZ512;
constexpr size_t WS_QB    = WS_VAT + SZ512;
constexpr size_t WS_KB    = WS_QB + SZ512;
constexpr size_t WS_VBT   = WS_KB + SZ512;
constexpr size_t WS_CQ    = WS_VBT + SZ512;
constexpr size_t WS_CK    = WS_CQ + SZ512;
constexpr size_t WS_CVT   = WS_CK + SZ512;
constexpr size_t WS_OG    = WS_CVT + SZ512;
constexpr size_t WS_QX    = WS_OG + SZ512;
constexpr size_t WS_Y     = WS_QX + SZ512;
constexpr size_t WS_STATE = WS_Y + (size_t)MP * DMIX * 2;
constexpr size_t WS_END   = WS_STATE + (size_t)2 * 4 * 16 * (16384 + 128) * 4;

struct Params {
    const float* in[18];
    float* out;
    unsigned char* ws;
    float inv_freq[8];
    int mode;
    int pad;
};

DI float bf2f(bf16_t v) { return __uint_as_float(((unsigned)v) << 16); }
DI unsigned pk2(float lo, float hi) { f32x2 v = {lo, hi}; bf16x2v b = __builtin_convertvector(v, bf16x2v); return __builtin_bit_cast(unsigned, b); }
DI bf16_t f2bf(float x) { return (bf16_t)(pk2(x, 0.f) & 0xffffu); }
DI float wave_sum(float v) {
#pragma unroll
    for (int o = 1; o < 64; o <<= 1) v += __shfl_xor(v, o);
    return v;
}
DI float sigmoidf_(float x) { return 1.f / (1.f + __expf(-x)); }
DI float siluf_(float x) { return x / (1.f + __expf(-x)); }
DI f32x4 mfma16(bf16x8 a, bf16x8 b, f32x4 c) { return __builtin_amdgcn_mfma_f32_16x16x32_bf16(a, b, c, 0, 0, 0); }
DI f32x16 mfma32(bf16x8 a, bf16x8 b, f32x16 c) { return __builtin_amdgcn_mfma_f32_32x32x16_bf16(a, b, c, 0, 0, 0); }
DI int opaque(int x) { asm volatile("" : "+v"(x)); return x; }
DI int crow(int r, int h2) { return (r & 3) + 8 * (r >> 2) + 4 * h2; }
DI void unpack8(u32x4 u, float* f) {
    f[0] = __uint_as_float(u.x << 16); f[1] = __uint_as_float(u.x & 0xffff0000u);
    f[2] = __uint_as_float(u.y << 16); f[3] = __uint_as_float(u.y & 0xffff0000u);
    f[4] = __uint_as_float(u.z << 16); f[5] = __uint_as_float(u.z & 0xffff0000u);
    f[6] = __uint_as_float(u.w << 16); f[7] = __uint_as_float(u.w & 0xffff0000u);
}
DI u32x4 pack8(const float* f) { u32x4 o; o.x = pk2(f[0], f[1]); o.y = pk2(f[2], f[3]); o.z = pk2(f[4], f[5]); o.w = pk2(f[6], f[7]); return o; }

DI void transpose_tile(const float* src, int ldsrc, int srccol0, const float* g, bf16_t* dst, int lddst, int k0, int n0, float* T, int tid) {
    const int n = tid & 63, kk = tid >> 6;
#pragma unroll
    for (int i = 0; i < 8; ++i) { const int k = kk + 8 * i; float v = src[(size_t)(k0 + k) * ldsrc + srccol0 + n]; if (g) v *= g[k0 + k]; T[k * 65 + n] = v; }
    __syncthreads();
    const int nn = tid >> 3, kc = tid & 7;
    float f[8];
#pragma unroll
    for (int i = 0; i < 8; ++i) f[i] = T[(8 * kc + i) * 65 + nn];
    *(u32x4*)(dst + (size_t)(n0 + nn) * lddst + k0 + 8 * kc) = pack8(f);
    __syncthreads();
}

DI void phase0(const Params& P, unsigned char* lds) {
    const int tid = opaque((int)threadIdx.x), bid = blockIdx.x, G = gridDim.x;
    unsigned char* ws = P.ws;
    float* T = (float*)lds;
    if (bid == 0) { for (int i = tid; i < 1024; i += NTHR) ((unsigned*)(ws + WS_CTL))[i] = 0u; }
    constexpr int T_IN = 16 * 120, T_OUT = 32 * 16, T_KV = 16 * 16;
    constexpr int NT = 2 * (T_IN + T_OUT + T_KV);
    for (int it = bid; it < NT; it += G) {
        int r = it; const int l = r / (T_IN + T_OUT + T_KV); r -= l * (T_IN + T_OUT + T_KV);
        if (r < T_IN) { const int kb = r / 120, nb = r % 120, n0 = nb * 64; const int sc = n0 < 6144 ? n0 : n0 + 8;
            transpose_tile(P.in[4] + (size_t)l * DM * NINO, NINO, sc, P.in[3] + l * DM, (bf16_t*)(ws + WS_WIN) + (size_t)l * NIN * DM, DM, kb * 64, n0, T, tid); continue; }
        r -= T_IN;
        if (r < T_OUT) { const int kb = r / 16, nb = r % 16;
            transpose_tile(P.in[17] + (size_t)l * DMIX * DM, DM, nb * 64, nullptr, (bf16_t*)(ws + WS_WOUT) + (size_t)l * DM * DMIX, DMIX, kb * 64, nb * 64, T, tid); continue; }
        r -= T_OUT;
        { const int kb = r / 16, nb = r % 16;
            transpose_tile(P.in[15] + (size_t)l * DM * DM, DM, nb * 64, P.in[14] + l * DM, (bf16_t*)(ws + WS_WKV) + (size_t)l * DM * DM, DM, kb * 64, nb * 64, T, tid); }
    }
    const int gt = bid * NTHR + tid, NG = G * NTHR;
    {
        const int* pos = (const int*)P.in[2];
        float* C = (float*)(ws + WS_COS); float* Sn = (float*)(ws + WS_SIN);
        for (int i = gt; i < 32768 * 8; i += NG) { const int row = i >> 3, j = i & 7; const float ang = (float)pos[row] * P.inv_freq[j]; C[i] = cosf(ang); Sn[i] = sinf(ang); }
    }
    { float* LB = (float*)(ws + WS_LB); const float* lg = P.in[6];
      for (int i = gt; i < 512; i += NG) { LB[i] = 0.f; LB[512 + i] = 1.f / (1.f + expf(lg[i] - lg[512 + i])); } }
    { const int lane = tid & 63, gw = (bid * NTHR + tid) >> 6, NGW = (G * NTHR) >> 6;
      for (int r = gw; r < 512; r += NGW) {
          const f32x4* xr = (const f32x4*)(P.in[1] + (size_t)r * DM) + lane; f32x4 v[4]; float s = 0.f;
#pragma unroll
          for (int j = 0; j < 4; ++j) { v[j] = xr[64 * j]; s += v[j].x * v[j].x + v[j].y * v[j].y + v[j].z * v[j].z + v[j].w * v[j].w; }
          const float rs = rsqrtf(wave_sum(s) * (1.f / DM) + EPS);
          u32x2* o = (u32x2*)((bf16_t*)(ws + WS_MNB) + (size_t)r * DM) + lane;
#pragma unroll
          for (int j = 0; j < 4; ++j) { u32x2 w; w.x = pk2(v[j].x * rs, v[j].y * rs); w.y = pk2(v[j].z * rs, v[j].w * rs); o[64 * j] = w; }
      } }
}

DI void prep_rows(const Params& P, const float* xsrc, int layer) {
    const int tid = opaque((int)threadIdx.x), lane = tid & 63, gw = (blockIdx.x * NTHR + tid) >> 6, NGW = (gridDim.x * NTHR) >> 6;
    unsigned char* ws = P.ws;
    const float* win = P.in[4] + (size_t)layer * DM * NINO; const float* ng = P.in[3] + layer * DM; const float* gb = P.in[5] + layer * 8;
    bf16_t* XB = (bf16_t*)(ws + WS_XB); float* RSTD = (float*)(ws + WS_RSTD); float* GATES = (float*)(ws + WS_GATES);
    for (int r = gw; r < MP; r += NGW) {
        const f32x4* xr = (const f32x4*)(xsrc + (size_t)r * DM) + lane; f32x4 v[4]; float s = 0.f;
#pragma unroll
        for (int j = 0; j < 4; ++j) { v[j] = xr[64 * j]; s += v[j].x * v[j].x + v[j].y * v[j].y + v[j].z * v[j].z + v[j].w * v[j].w; }
        const float rs = rsqrtf(wave_sum(s) * (1.f / DM) + EPS);
        u32x2* o = (u32x2*)(XB + (size_t)r * DM) + lane;
#pragma unroll
        for (int j = 0; j < 4; ++j) { u32x2 w; w.x = pk2(v[j].x, v[j].y); w.y = pk2(v[j].z, v[j].w); o[64 * j] = w; }
        float d[8];
#pragma unroll
        for (int g = 0; g < 8; ++g) d[g] = 0.f;
#pragma unroll
        for (int j = 0; j < 4; ++j) {
#pragma unroll
            for (int e = 0; e < 4; ++e) { const int k = 4 * lane + 256 * j + e; const float xv = v[j][e] * ng[k];
                const f32x4 w0 = *(const f32x4*)(win + (size_t)k * NINO + 6144); const f32x4 w1 = *(const f32x4*)(win + (size_t)k * NINO + 6148);
                d[0] += xv * w0.x; d[1] += xv * w0.y; d[2] += xv * w0.z; d[3] += xv * w0.w; d[4] += xv * w1.x; d[5] += xv * w1.y; d[6] += xv * w1.z; d[7] += xv * w1.w; }
        }
#pragma unroll
        for (int g = 0; g < 8; ++g) d[g] = wave_sum(d[g]) * rs;
        if (lane == 0) {
            RSTD[r] = rs;
            f32x4 gi, gf;
#pragma unroll
            for (int g = 0; g < 4; ++g) { gi[g] = d[g] + gb[g]; const float z = d[4 + g] + gb[4 + g]; gf[g] = fminf(z, 0.f) - log1pf(expf(-fabsf(z))); }
            *(f32x4*)(GATES + (size_t)r * 8) = gi; *(f32x4*)(GATES + (size_t)r * 8 + 4) = gf;
        }
    }
}

DI void gemm_tile(const bf16_t* A, int lda, const bf16_t* Bt, int ldb, int K, int row0, int col0, unsigned char* lds) {
    const int tid = opaque((int)threadIdx.x), lane = tid & 63, w = __builtin_amdgcn_readfirstlane(tid >> 6), wr = w >> 2, wc = w & 3, fr = lane & 15, fq = lane >> 4;
    f32x4 acc[4][2];
#pragma unroll
    for (int m = 0; m < 4; ++m)
#pragma unroll
        for (int n = 0; n < 2; ++n) acc[m][n] = (f32x4){0.f, 0.f, 0.f, 0.f};
    u32x4 ra[2], rb[2];
    const int nt = K / 64;
    int sr[2], sc[2], so[2];
#pragma unroll
    for (int i = 0; i < 2; ++i) { const int c = tid + NTHR * i; sr[i] = c >> 3; sc[i] = c & 7; so[i] = sr[i] * 128 + ((sc[i] ^ (sr[i] & 7)) << 4); }
#pragma unroll
    for (int i = 0; i < 2; ++i) { ra[i] = *(const u32x4*)(A + (size_t)(row0 + sr[i]) * lda + sc[i] * 8); rb[i] = *(const u32x4*)(Bt + (size_t)(col0 + sr[i]) * ldb + sc[i] * 8); }
#pragma unroll
    for (int i = 0; i < 2; ++i) { *(u32x4*)(lds + so[i]) = ra[i]; *(u32x4*)(lds + 16384 + so[i]) = rb[i]; }
    __syncthreads();
    for (int t = 0; t < nt; ++t) {
        const unsigned char* LA = lds + (t & 1) * 32768; const unsigned char* LB = LA + 16384;
        if (t + 1 < nt) {
#pragma unroll
            for (int i = 0; i < 2; ++i) { ra[i] = *(const u32x4*)(A + (size_t)(row0 + sr[i]) * lda + (t + 1) * 64 + sc[i] * 8); rb[i] = *(const u32x4*)(Bt + (size_t)(col0 + sr[i]) * ldb + (t + 1) * 64 + sc[i] * 8); }
        }
#pragma unroll
        for (int kk = 0; kk < 2; ++kk) {
            bf16x8 af[4], bfr[2]; const int ch = kk * 4 + fq;
#pragma unroll
            for (int m = 0; m < 4; ++m) { const int r = wr * 64 + m * 16 + fr; af[m] = *(const bf16x8*)(LA + r * 128 + ((ch ^ (r & 7)) << 4)); }
#pragma unroll
            for (int n = 0; n < 2; ++n) { const int r = wc * 32 + n * 16 + fr; bfr[n] = *(const bf16x8*)(LB + r * 128 + ((ch ^ (r & 7)) << 4)); }
#pragma unroll
            for (int m = 0; m < 4; ++m)
#pragma unroll
                for (int n = 0; n < 2; ++n) acc[m][n] = mfma16(af[m], bfr[n], acc[m][n]);
        }
        if (t + 1 < nt) {
            unsigned char* NA = lds + ((t + 1) & 1) * 32768;
#pragma unroll
            for (int i = 0; i < 2; ++i) { *(u32x4*)(NA + so[i]) = ra[i]; *(u32x4*)(NA + 16384 + so[i]) = rb[i]; }
        }
        __syncthreads();
    }
    float* T = (float*)lds;
#pragma unroll
    for (int m = 0; m < 4; ++m)
#pragma unroll
        for (int n = 0; n < 2; ++n)
#pragma unroll
            for (int r = 0; r < 4; ++r) T[(wr * 64 + m * 16 + 4 * fq + r) * 132 + wc * 32 + n * 16 + fr] = acc[m][n][r];
    __syncthreads();
}

DI void epi_inproj(const Params& P, const float* T, int row0, int col0, int layer, int batch) {
    const int tid = opaque((int)threadIdx.x); unsigned char* ws = P.ws;
    const int seg = col0 >> 9, cseg = col0 & 511;
    const float* RSTD = (const float*)(ws + WS_RSTD);
    const bool transposed = (seg == 2 || seg == 6 || seg == 10);
    if (transposed) {
        bf16_t* dst = (bf16_t*)(ws + (seg == 2 ? WS_VAT : (seg == 6 ? WS_VBT : WS_CVT)));
#pragma unroll
        for (int j = 0; j < 4; ++j) { const int item = tid + NTHR * j, rc = item & 15, col = item >> 4; float f[8];
#pragma unroll
            for (int i = 0; i < 8; ++i) f[i] = T[(rc * 8 + i) * 132 + col] * RSTD[row0 + rc * 8 + i];
            *(u32x4*)(dst + (size_t)(cseg + col) * MP + row0 + rc * 8) = pack8(f); }
        return;
    }
    const float* LB = (const float*)(ws + WS_LB) + layer * 512;
    const float* COSt = (const float*)(ws + WS_COS); const float* SINt = (const float*)(ws + WS_SIN);
#pragma unroll
    for (int j = 0; j < 4; ++j) {
        const int item = tid + NTHR * j, r = item >> 4, ch = item & 15, row = row0 + r, c = cseg + ch * 8;
        const float rs = RSTD[row]; float v[8];
        { const f32x4 a = *(const f32x4*)(T + r * 132 + ch * 8), b = *(const f32x4*)(T + r * 132 + ch * 8 + 4);
          v[0] = a.x * rs; v[1] = a.y * rs; v[2] = a.z * rs; v[3] = a.w * rs; v[4] = b.x * rs; v[5] = b.y * rs; v[6] = b.z * rs; v[7] = b.w * rs; }
        bf16_t* dst = nullptr; size_t doff = (size_t)row * 512 + c;
        switch (seg) {
        case 0: { dst = (bf16_t*)(ws + WS_QA);
#pragma unroll
            for (int i = 0; i < 8; ++i) v[i] = siluf_(v[i]) * 0.08838834764831845f; } break;
        case 1: { dst = (bf16_t*)(ws + WS_LF);
#pragma unroll
            for (int i = 0; i < 8; ++i) { const float lb = LB[c + i]; v[i] = logf(fmaxf(lb + (1.f - lb) * sigmoidf_(v[i]), 1e-30f)); } } break;
        case 3: case 7: case 12: case 14: { dst = (bf16_t*)(ws + WS_Y); doff = (size_t)row * DMIX + (seg == 3 ? 0 : (seg == 7 ? 512 : (seg == 12 ? 1024 : 1536))) + c;
#pragma unroll
            for (int i = 0; i < 8; ++i) v[i] = siluf_(v[i]); } break;
        case 4: case 5: {
            dst = (bf16_t*)(ws + (seg == 4 ? WS_QB : WS_KB));
            float ss = 0.f;
#pragma unroll
            for (int i = 0; i < 8; ++i) ss += v[i] * v[i];
            ss += __shfl_xor(ss, 1); ss += __shfl_xor(ss, 2); ss += __shfl_xor(ss, 4);
            const float rn = rsqrtf(ss * (1.f / 64.f) + EPS);
            const float* g = P.in[8] + layer * 128 + (seg == 4 ? 0 : 64) + (ch & 7) * 8;
            const int grow = batch * SEQ + row; const int c7 = ch & 7;
            const float sc = (seg == 4) ? 0.125f : 1.f;
#pragma unroll
            for (int i = 0; i < 8; ++i) {
                float y = v[i] * rn * g[i];
                const float part = __shfl_xor(y, 1);
                const float cs = COSt[grow * 8 + i], sn = SINt[grow * 8 + i];
                if (c7 == 0) y = y * cs - part * sn; else if (c7 == 1) y = y * cs + part * sn;
                v[i] = y * sc;
            } } break;
        case 8: dst = (bf16_t*)(ws + WS_CQ); break;
        case 9: dst = (bf16_t*)(ws + WS_CK); break;
        case 11: { dst = (bf16_t*)(ws + WS_OG);
#pragma unroll
            for (int i = 0; i < 8; ++i) v[i] = sigmoidf_(v[i]); } break;
        case 13: { dst = (bf16_t*)(ws + WS_QX);
            float ss = 0.f;
#pragma unroll
            for (int i = 0; i < 8; ++i) ss += v[i] * v[i];
            ss += __shfl_xor(ss, 1); ss += __shfl_xor(ss, 2); ss += __shfl_xor(ss, 4); ss += __shfl_xor(ss, 8);
            const float rn = rsqrtf(ss * (1.f / 128.f) + EPS) * 0.08838834764831845f;
            const float* g = P.in[16] + layer * 256 + ch * 8;
#pragma unroll
            for (int i = 0; i < 8; ++i) v[i] = v[i] * rn * g[i]; } break;
        default: break;
        }
        *(u32x4*)(dst + doff) = pack8(v);
    }
}

DI void epi_kvmem(const Params& P, const float* T, int row0, int col0, int layer) {
    const int tid = opaque((int)threadIdx.x); unsigned char* ws = P.ws;
    if (col0 < 512) {
        bf16_t* dst = (bf16_t*)(ws + WS_KMB) + (size_t)layer * 512 * 512;
        const float* g = P.in[16] + layer * 256 + 128;
#pragma unroll
        for (int j = 0; j < 4; ++j) { const int item = tid + NTHR * j, r = item >> 4, ch = item & 15; float v[8];
            { const f32x4 a = *(const f32x4*)(T + r * 132 + ch * 8), b = *(const f32x4*)(T + r * 132 + ch * 8 + 4);
              v[0] = a.x; v[1] = a.y; v[2] = a.z; v[3] = a.w; v[4] = b.x; v[5] = b.y; v[6] = b.z; v[7] = b.w; }
            float ss = 0.f;
#pragma unroll
            for (int i = 0; i < 8; ++i) ss += v[i] * v[i];
            ss += __shfl_xor(ss, 1); ss += __shfl_xor(ss, 2); ss += __shfl_xor(ss, 4); ss += __shfl_xor(ss, 8);
            const float rn = rsqrtf(ss * (1.f / 128.f) + EPS);
#pragma unroll
            for (int i = 0; i < 8; ++i) v[i] = v[i] * rn * g[ch * 8 + i];
            *(u32x4*)(dst + (size_t)(row0 + r) * 512 + col0 + ch * 8) = pack8(v); }
    } else {
        const int b = row0 >> 8, m0 = row0 & 255;
        bf16_t* dst = (bf16_t*)(ws + WS_VMT) + (size_t)(layer * 2 + b) * 512 * 256;
#pragma unroll
        for (int j = 0; j < 4; ++j) { const int item = tid + NTHR * j, rc = item & 15, col = item >> 4; float f[8];
#pragma unroll
            for (int i = 0; i < 8; ++i) f[i] = T[(rc * 8 + i) * 132 + col];
            *(u32x4*)(dst + (size_t)(col0 - 512 + col) * 256 + m0 + rc * 8) = pack8(f); }
    }
}

DI void epi_outproj(const float* T, const float* xold, float* out, int grow0, int col0) {
    const int tid = opaque((int)threadIdx.x);
#pragma unroll
    for (int j = 0; j < 8; ++j) { const int item = tid + NTHR * j, r = item >> 5, c4 = item & 31;
        const size_t off = (size_t)(grow0 + r) * DM + col0 + c4 * 4;
        const f32x4 a = *(const f32x4*)(T + r * 132 + c4 * 4), x = *(const f32x4*)(xold + off);
        *(f32x4*)(out + off) = a + x; }
}

template <int NCOMP>
DI void attn_unit(const Params& P, unsigned char* lds, int layer, int batch, int h, int qb) {
    constexpr int NS = (NCOMP == 2) ? 4 : 8;
    constexpr int STG = 64 * 272 + 128 * 136;
    const int tid = opaque((int)threadIdx.x), lane = tid & 63, w = __builtin_amdgcn_readfirstlane(tid >> 6), l31 = lane & 31, h2 = lane >> 5;
    unsigned char* ws = P.ws;
    const int comp = (NCOMP == 2) ? (w >> 2) : 0;
    const int q0 = (NCOMP == 2) ? qb * 128 : qb * 256;
    const int qw = (NCOMP == 2) ? q0 + 32 * (w & 3) : q0 + 32 * w;
    const bf16_t* Qsrc = (const bf16_t*)(ws + (NCOMP == 2 ? WS_QB : WS_QX));
    const bf16_t* Ksrc; const bf16_t* Vsrc; int ldv, nkt;
    if (NCOMP == 2) { Ksrc = (const bf16_t*)(ws + WS_KB) + h * 128; Vsrc = (const bf16_t*)(ws + WS_VBT) + (size_t)(h * 128) * MP; ldv = MP; nkt = 2 * qb + 2; }
    else { Ksrc = (const bf16_t*)(ws + WS_KMB) + (size_t)layer * 512 * 512 + (size_t)batch * 256 * 512 + h * 128;
           Vsrc = (const bf16_t*)(ws + WS_VMT) + (size_t)(layer * 2 + batch) * 512 * 256 + (size_t)(h * 128) * 256; ldv = 256; nkt = 4; }
    bf16x8 qf[NS];
    { const bf16_t* qp = Qsrc + (size_t)(qw + l31) * 512 + h * 128 + comp * 64 + 8 * h2;
#pragma unroll
      for (int s = 0; s < NS; ++s) qf[s] = *(const bf16x8*)(qp + 16 * s);
      asm volatile("s_waitcnt vmcnt(0)" ::: "memory");
#pragma unroll
      for (int s = 0; s < NS; ++s) asm volatile("" : "+v"(qf[s])); }
    f32x16 O[4];
#pragma unroll
    for (int d = 0; d < 4; ++d)
#pragma unroll
        for (int i = 0; i < 16; ++i) O[d][i] = 0.f;
    float mrun = -1e30f, lsum = 0.f;
    u32x4 rk[2], rv[2]; int kr[2], kc[2], vr[2], vc[2];
#pragma unroll
    for (int i = 0; i < 2; ++i) { const int c = tid + NTHR * i; kr[i] = c >> 4; kc[i] = c & 15; vr[i] = c >> 3; vc[i] = c & 7; }
#pragma unroll
    for (int i = 0; i < 2; ++i) { rk[i] = *(const u32x4*)(Ksrc + (size_t)kr[i] * 512 + kc[i] * 8); rv[i] = *(const u32x4*)(Vsrc + (size_t)vr[i] * ldv + vc[i] * 8); }
#pragma unroll
    for (int i = 0; i < 2; ++i) { *(u32x4*)(lds + kr[i] * 272 + kc[i] * 16) = rk[i];
        unsigned char* vp = lds + 64 * 272 + vr[i] * 136 + vc[i] * 16; *(u32x2*)vp = (u32x2){rv[i].x, rv[i].y}; *(u32x2*)(vp + 8) = (u32x2){rv[i].z, rv[i].w}; }
    __syncthreads();
    for (int kt = 0; kt < nkt; ++kt) {
        const unsigned char* LK = lds + (kt & 1) * STG; const unsigned char* LV = LK + 64 * 272;
        if (kt + 1 < nkt) {
#pragma unroll
            for (int i = 0; i < 2; ++i) { rk[i] = *(const u32x4*)(Ksrc + (size_t)((kt + 1) * 64 + kr[i]) * 512 + kc[i] * 8); rv[i] = *(const u32x4*)(Vsrc + (size_t)vr[i] * ldv + (kt + 1) * 64 + vc[i] * 8); }
        }
        const bool active = (NCOMP == 1) || (kt * 64 <= qw + 31);
        if (active) {
#pragma unroll
            for (int kb = 0; kb < 2; ++kb) {
                f32x16 S;
#pragma unroll
                for (int i = 0; i < 16; ++i) S[i] = 0.f;
#pragma unroll
                for (int s = 0; s < NS; ++s) { const bf16x8 kf = *(const bf16x8*)(LK + (32 * kb + l31) * 272 + comp * 128 + (16 * s + 8 * h2) * 2); S = mfma32(kf, qf[s], S); }
                if (NCOMP == 2 && (kt * 64 + 32 * kb + 31 > qw)) {
                    const int qpos = qw + l31;
#pragma unroll
                    for (int i = 0; i < 16; ++i) { const int key = kt * 64 + 32 * kb + crow(i, h2); if (key > qpos) S[i] = -1e30f; }
                }
                float mx = S[0];
#pragma unroll
                for (int i = 1; i < 16; ++i) mx = fmaxf(mx, S[i]);
                mx = fmaxf(mx, __shfl_xor(mx, 32));
                const float mnew = fmaxf(mrun, mx), alpha = __expf(mrun - mnew);
                mrun = mnew;
                float ps = 0.f;
#pragma unroll
                for (int i = 0; i < 16; ++i) { const float p = __expf(S[i] - mnew); S[i] = p; ps += p; }
                lsum = lsum * alpha + ps;
#pragma unroll
                for (int d = 0; d < 4; ++d)
#pragma unroll
                    for (int i = 0; i < 16; ++i) O[d][i] *= alpha;
#pragma unroll
                for (int s2 = 0; s2 < 2; ++s2) {
                    u32x4 pp; pp.x = pk2(S[8 * s2 + 0], S[8 * s2 + 1]); pp.y = pk2(S[8 * s2 + 2], S[8 * s2 + 3]); pp.z = pk2(S[8 * s2 + 4], S[8 * s2 + 5]); pp.w = pk2(S[8 * s2 + 6], S[8 * s2 + 7]);
                    const bf16x8 pf = __builtin_bit_cast(bf16x8, pp);
#pragma unroll
                    for (int d = 0; d < 4; ++d) {
                        const unsigned char* vp = LV + (32 * d + l31) * 136 + (32 * kb + 16 * s2 + 4 * h2) * 2;
                        const s16x4 lo = *(const s16x4*)vp, hi = *(const s16x4*)(vp + 16);
                        const bf16x8 vf = __builtin_shufflevector(lo, hi, 0, 1, 2, 3, 4, 5, 6, 7);
                        O[d] = mfma32(vf, pf, O[d]);
                    }
                }
            }
        }
        if (kt + 1 < nkt) {
            unsigned char* NK = lds + ((kt + 1) & 1) * STG;
#pragma unroll
            for (int i = 0; i < 2; ++i) { *(u32x4*)(NK + kr[i] * 272 + kc[i] * 16) = rk[i];
                unsigned char* vp = NK + 64 * 272 + vr[i] * 136 + vc[i] * 16; *(u32x2*)vp = (u32x2){rv[i].x, rv[i].y}; *(u32x2*)(vp + 8) = (u32x2){rv[i].z, rv[i].w}; }
        }
        __syncthreads();
    }
    const float inv = 1.f / (lsum + __shfl_xor(lsum, 32));
#pragma unroll
    for (int d = 0; d < 4; ++d)
#pragma unroll
        for (int i = 0; i < 16; ++i) O[d][i] *= inv;
    bf16_t* Y = (bf16_t*)(ws + WS_Y);
    if (NCOMP == 1) {
        bf16_t* yp = Y + (size_t)(qw + l31) * DMIX + 1536 + h * 128;
#pragma unroll
        for (int d = 0; d < 4; ++d)
#pragma unroll
            for (int g = 0; g < 4; ++g) { const int dv = 32 * d + 8 * g + 4 * h2; const u32x2 gt = *(const u32x2*)(yp + dv);
                u32x2 o; o.x = pk2(O[d][4 * g + 0] * __uint_as_float(gt.x << 16), O[d][4 * g + 1] * __uint_as_float(gt.x & 0xffff0000u));
                o.y = pk2(O[d][4 * g + 2] * __uint_as_float(gt.y << 16), O[d][4 * g + 3] * __uint_as_float(gt.y & 0xffff0000u));
                *(u32x2*)(yp + dv) = o; }
        __syncthreads();
        return;
    }
    float* X = (float*)lds;
    const int ql = 32 * (w & 3) + l31;
    if (comp == 1) {
#pragma unroll
        for (int d = 0; d < 4; ++d)
#pragma unroll
            for (int i = 0; i < 16; ++i) X[ql * 132 + 32 * d + crow(i, h2)] = O[d][i];
    }
    __syncthreads();
    const float* lp = P.in[9] + layer * 256;
    float lam;
    { const float a = wave_sum(lp[lane] * lp[64 + lane]), b = wave_sum(lp[128 + lane] * lp[192 + lane]);
      const float lam_init = 0.8f - 0.6f * expf(-0.3f * (float)layer); lam = expf(a) - expf(b) + lam_init; }
    if (comp == 0) {
#pragma unroll
        for (int d = 0; d < 4; ++d)
#pragma unroll
            for (int i = 0; i < 16; ++i) { const int a = ql * 132 + 32 * d + crow(i, h2); X[a] = O[d][i] - lam * X[a]; }
    }
    __syncthreads();
    {
        const float lam_init = 0.8f - 0.6f * expf(-0.3f * (float)layer);
        const float* g = P.in[10] + layer * 128;
#pragma unroll
        for (int j = 0; j < 4; ++j) { const int item = tid + NTHR * j, r = item >> 4, ch = item & 15; float v[8];
            { const f32x4 a = *(const f32x4*)(X + r * 132 + ch * 8), b = *(const f32x4*)(X + r * 132 + ch * 8 + 4);
              v[0] = a.x; v[1] = a.y; v[2] = a.z; v[3] = a.w; v[4] = b.x; v[5] = b.y; v[6] = b.z; v[7] = b.w; }
            float ss = 0.f;
#pragma unroll
            for (int i = 0; i < 8; ++i) ss += v[i] * v[i];
            ss += __shfl_xor(ss, 1); ss += __shfl_xor(ss, 2); ss += __shfl_xor(ss, 4); ss += __shfl_xor(ss, 8);
            const float rn = rsqrtf(ss * (1.f / 128.f) + EPS) * (1.f - lam_init);
            bf16_t* yp = Y + (size_t)(q0 + r) * DMIX + 512 + h * 128 + ch * 8; float gt[8]; unpack8(*(const u32x4*)yp, gt);
#pragma unroll
            for (int i = 0; i < 8; ++i) v[i] = v[i] * rn * g[ch * 8 + i] * gt[i];
            *(u32x4*)yp = pack8(v); }
    }
    __syncthreads();
}

constexpr int NSEG = 16, CPS = 16;
constexpr int SIN_FLOATS = 16384 + 128;
constexpr int CH_QT = 0, CH_KT = 17408, CH_QH = 34816, CH_KHT = 52224, CH_VT = 70656, CH_AM = 89088, CH_OB = 98304, CH_PART = 132096,
              CH_DEC = 134144, CH_NV = 134656  , CH_SC = 135680  , CH_MC = 136704  ,
              CH_DT = 137728  , CH_NL = 138240  ;

template <int MODE, bool FULL>
DI void chain_prep(const Params& P, unsigned char* lds, int layer, int h, int t0, int tid, int lane, int w, int k, int tg, float mcar) {
    unsigned char* ws = P.ws;
    bf16_t* QT = (bf16_t*)(lds + CH_QT); bf16_t* KT = (bf16_t*)(lds + CH_KT); bf16_t* QH = (bf16_t*)(lds + CH_QH);
    float* PART = (float*)(lds + CH_PART); float* DEC = (float*)(lds + CH_DEC);
    float* SCA = (float*)(lds + CH_SC); float* SCM = SCA + 64; float* SCWI = SCA + 128; float* SCE = SCA + 192;
    const bf16_t* Vsrc = (const bf16_t*)(ws + (MODE == 0 ? WS_VAT : WS_CVT)) + (size_t)(h * 128) * MP;
#pragma unroll
    for (int i = 0; i < 2; ++i) { const int c = tid + NTHR * i, dv = c >> 3, ch = c & 7;
        *(u32x4*)(lds + CH_VT + dv * 144 + ch * 16) = *(const u32x4*)(Vsrc + (size_t)dv * MP + t0 + ch * 8); }
    float khv[16];
    if (MODE == 0) {
        const bf16_t* LFp = (const bf16_t*)(ws + WS_LF) + (size_t)(t0 + 16 * tg) * 512 + h * 128 + k;
        const bf16_t* QAp = (const bf16_t*)(ws + WS_QA) + (size_t)(t0 + 16 * tg) * 512 + h * 128 + k;
        float lf[16], q[16]; float part = 0.f;
#pragma unroll
        for (int i = 0; i < 16; ++i) { lf[i] = bf2f(LFp[(size_t)i * 512]); if (FULL) q[i] = bf2f(QAp[(size_t)i * 512]); part += lf[i]; }
        PART[tg * 128 + k] = part;
        __syncthreads();
        const float p0 = PART[k], p1 = PART[128 + k], p2 = PART[256 + k], p3 = PART[384 + k];
        const float bmid = p0 + p1, total = bmid + p2 + p3;
        float run = (tg > 0 ? p0 : 0.f) + (tg > 1 ? p1 : 0.f) + (tg > 2 ? p2 : 0.f);
#pragma unroll
        for (int i = 0; i < 16; ++i) { run += lf[i]; const float f = __expf(lf[i]), kk = 1.f - f; const int t = 16 * tg + i;
            if (FULL) { QT[t * 136 + k] = f2bf(q[i] * __expf(run - bmid)); KT[t * 136 + k] = f2bf(kk * __expf(bmid - run)); QH[t * 136 + k] = f2bf(q[i] * __expf(run)); }
            khv[i] = kk * __expf(total - run); }
        if (tg == 0) DEC[k] = __expf(total);
    } else {
        const float* GT = (const float*)(ws + WS_GATES) + (size_t)(t0 + lane) * 8;
        const float li = GT[h], lfg = GT[4 + h];
        float b = lfg;
#pragma unroll
        for (int o = 1; o < 64; o <<= 1) { const float x = __shfl_up(b, o); if (lane >= o) b += x; }
        const float a = li - b; float pm = a;
#pragma unroll
        for (int o = 1; o < 64; o <<= 1) { const float x = __shfl_up(pm, o); if (lane >= o) pm = fmaxf(pm, x); }
        const float M = fmaxf(pm, mcar), wi = __expf(mcar - M);
        const float M63 = __shfl(M, 63);
        const float wg = __expf(a - M63), dec = __expf(mcar - M63);
        if (FULL && w == 0) { SCA[lane] = a; SCM[lane] = M; SCWI[lane] = wi; SCE[lane] = __expf(-(b + M)); }
        if (tg == 0) DEC[k] = dec;
        float wq[4], wk[4], bq, bk;
        { const float* cw = P.in[11] + layer * 4096; const float* cb = P.in[12] + layer * 1024;
#pragma unroll
          for (int j = 0; j < 4; ++j) { wq[j] = cw[j * 1024 + h * 128 + k]; wk[j] = cw[j * 1024 + 512 + h * 128 + k]; }
          bq = cb[h * 128 + k]; bk = cb[512 + h * 128 + k]; }
        const bf16_t* CQp = (const bf16_t*)(ws + WS_CQ) + h * 128 + k; const bf16_t* CKp = (const bf16_t*)(ws + WS_CK) + h * 128 + k;
#pragma unroll
        for (int hf = 0; hf < 2; ++hf) {
            float rq[11], rkk[11];
#pragma unroll
            for (int i = 0; i < 11; ++i) { const int t = t0 + 16 * tg + 8 * hf - 3 + i; const bool ok = t >= 0; const size_t tt = ok ? (size_t)t : 0;
                const float kx = bf2f(CKp[tt * 512]); rkk[i] = ok ? kx : 0.f;
                if (FULL) { const float qx = bf2f(CQp[tt * 512]); rq[i] = ok ? qx : 0.f; } else rq[i] = 0.f; }
#pragma unroll
            for (int i = 0; i < 8; ++i) {
                const float kv = siluf_(bk + wk[0] * rkk[i] + wk[1] * rkk[i + 1] + wk[2] * rkk[i + 2] + wk[3] * rkk[i + 3]) * 0.08838834764831845f;
                const int t = 16 * tg + 8 * hf + i; const float wgt = __shfl(wg, t);
                if (FULL) { const float qv = siluf_(bq + wq[0] * rq[i] + wq[1] * rq[i + 1] + wq[2] * rq[i + 2] + wq[3] * rq[i + 3]); const float wit = __shfl(wi, t);
                    QT[t * 136 + k] = f2bf(qv); KT[t * 136 + k] = f2bf(kv); QH[t * 136 + k] = f2bf(qv * wit); }
                khv[8 * hf + i] = kv * wgt; }
        }
    }
    { unsigned char* kp = lds + CH_KHT + k * 144 + tg * 32; *(u32x4*)kp = pack8(khv); *(u32x4*)(kp + 16) = pack8(khv + 8); }
}

template <int MODE  >
DI void chain_unit(const Params& P, unsigned char* lds, int layer, int batch, int h, int seg, unsigned* flags  ) {
    const int tid = opaque((int)threadIdx.x), lane = tid & 63, w = __builtin_amdgcn_readfirstlane(tid >> 6), fr = lane & 15, fq = lane >> 4;
    const int k = tid & 127, tg = w >> 1;
    unsigned char* ws = P.ws;
    float* OB = (float*)(lds + CH_OB); float* DEC = (float*)(lds + CH_DEC);
    float* NV = (float*)(lds + CH_NV); float* SCA = (float*)(lds + CH_SC); float* SCM = SCA + 64; float* SCWI = SCA + 128; float* SCE = SCA + 192;
    float* MC = (float*)(lds + CH_MC); float* DT = (float*)(lds + CH_DT); float* NL = (float*)(lds + CH_NL);
    bf16_t* Y = (bf16_t*)(ws + WS_Y);
    float* SIN = (float*)(ws + WS_STATE) + (size_t)((MODE * 4 + h) * NSEG) * SIN_FLOATS;
    if (MODE == 1) {
        float* SB = OB; float* SP = OB + 256;
        if (tid < 256) { const float* GT = (const float*)(ws + WS_GATES) + (size_t)(tid * 64) * 8; float b = 0.f, pm = -1e30f;
#pragma unroll 8
            for (int s = 0; s < 64; ++s) { b += GT[s * 8 + 4 + h]; pm = fmaxf(pm, GT[s * 8 + h] - b); }
            SB[tid] = b; SP[tid] = pm; }
        __syncthreads();
        if (tid == 0) { float m = 0.f;
#pragma unroll 1
            for (int c = 0; c < 256; ++c) { MC[c] = m; m = SB[c] + fmaxf(SP[c], m); } }
        __syncthreads();
    }
    f32x4 Sacc[8];
#pragma unroll
    for (int i = 0; i < 8; ++i) Sacc[i] = (f32x4){0.f, 0.f, 0.f, 0.f};
    float dtot = 1.f, nloc = 0.f;
    if (seg < NSEG - 1) {
#pragma unroll 1
        for (int cc = 0; cc < CPS; ++cc) {
            const int chunk = seg * CPS + cc, t0 = chunk * 64;
            const float mcar = (MODE == 1) ? MC[chunk] : 0.f;
            chain_prep<MODE, false>(P, lds, layer, h, t0, tid, lane, w, k, tg, mcar);
            __syncthreads();
            if (tid < 128) { const float d = DEC[tid]; dtot *= d;
                if (MODE == 1) { float sum = 0.f;
#pragma unroll
                    for (int c8 = 0; c8 < 8; ++c8) { float f[8]; unpack8(*(const u32x4*)(lds + CH_KHT + tid * 144 + c8 * 16), f);
#pragma unroll
                        for (int i = 0; i < 8; ++i) sum += f[i]; }
                    nloc = d * nloc + sum; } }
            bf16x8 vf[2];
#pragma unroll
            for (int ks = 0; ks < 2; ++ks) vf[ks] = *(const bf16x8*)(lds + CH_VT + (16 * w + fr) * 144 + (32 * ks + 8 * fq) * 2);
#pragma unroll
            for (int mb = 0; mb < 8; ++mb) { const f32x4 d = *(const f32x4*)(DEC + 16 * mb + 4 * fq); Sacc[mb] = Sacc[mb] * d;
#pragma unroll
                for (int ks = 0; ks < 2; ++ks) { const bf16x8 af = *(const bf16x8*)(lds + CH_KHT + (16 * mb + fr) * 144 + (32 * ks + 8 * fq) * 2); Sacc[mb] = mfma16(af, vf[ks], Sacc[mb]); } }
            __syncthreads();
        }
    }
    if (tid < 128) { DT[tid] = dtot; NL[tid] = nloc; }
    if (seg > 0) {
        if (tid == 0) { while (__hip_atomic_load(flags + seg, __ATOMIC_RELAXED, __HIP_MEMORY_SCOPE_AGENT) == 0u) __builtin_amdgcn_s_sleep(4); }
        __syncthreads();
        __threadfence();
    } else __syncthreads();
    {
        float* sin_me = SIN + (size_t)seg * SIN_FLOATS; float* sin_nx = SIN + (size_t)(seg + 1) * SIN_FLOATS;
        float n_in = 0.f;
        if (seg > 0 && tid < 128) n_in = __hip_atomic_load(sin_me + 16384 + tid, __ATOMIC_RELAXED, __HIP_MEMORY_SCOPE_AGENT);
#pragma unroll
        for (int mb = 0; mb < 8; ++mb) {
            f32x4 sin = (f32x4){0.f, 0.f, 0.f, 0.f};
            if (seg > 0) sin = *(const f32x4*)(sin_me + ((w * 8 + mb) * 64 + lane) * 4);
            if (seg < NSEG - 1) { const f32x4 d = *(const f32x4*)(DT + 16 * mb + 4 * fq); *(f32x4*)(sin_nx + ((w * 8 + mb) * 64 + lane) * 4) = d * sin + Sacc[mb]; }
            Sacc[mb] = sin;
        }
        if (tid < 128) { if (seg < NSEG - 1) sin_nx[16384 + tid] = dtot * n_in + nloc; if (MODE == 1) NV[tid] = n_in; }
        if (seg < NSEG - 1) {
            __threadfence();
            __syncthreads();
            if (tid == 0) __hip_atomic_store(flags + seg + 1, 1u, __ATOMIC_RELEASE, __HIP_MEMORY_SCOPE_AGENT);
        }
    }
    __syncthreads();
#pragma unroll 1
    for (int cc = 0; cc < CPS; ++cc) {
        const int chunk = seg * CPS + cc, t0 = chunk * 64;
        const float mcar = (MODE == 1) ? MC[chunk] : 0.f;
        chain_prep<MODE, true>(P, lds, layer, h, t0, tid, lane, w, k, tg, mcar);
        __syncthreads();
        {
            const int mb = w >> 1;
#pragma unroll
            for (int nn = 0; nn < 2; ++nn) { const int nb = (w & 1) * 2 + nn; f32x4 acc = (f32x4){0.f, 0.f, 0.f, 0.f};
                if (nb <= mb) {
#pragma unroll
                    for (int ks = 0; ks < 4; ++ks) { const bf16x8 af = *(const bf16x8*)(lds + CH_QT + (16 * mb + fr) * 272 + (32 * ks + 8 * fq) * 2);
                        const bf16x8 bfv = *(const bf16x8*)(lds + CH_KT + (16 * nb + fr) * 272 + (32 * ks + 8 * fq) * 2); acc = mfma16(af, bfv, acc); }
                }
                const int s = 16 * nb + fr; float as = 0.f; if (MODE == 1) as = SCA[s];
#pragma unroll
                for (int r = 0; r < 4; ++r) { const int t = 16 * mb + 4 * fq + r; float v = 0.f;
                    if (s <= t) { v = acc[r]; if (MODE == 1) v *= __expf(as - SCM[t]); }
                    ((bf16_t*)(lds + CH_AM))[t * 72 + s] = f2bf(v); }
            }
        }
        if (MODE == 1 && tid < 128) { float sum = 0.f;
#pragma unroll
            for (int c8 = 0; c8 < 8; ++c8) { float f[8]; unpack8(*(const u32x4*)(lds + CH_KHT + tid * 144 + c8 * 16), f);
#pragma unroll
                for (int i = 0; i < 8; ++i) sum += f[i]; }
            NV[((cc + 1) & 1) * 128 + tid] = DEC[tid] * NV[(cc & 1) * 128 + tid] + sum; }
        __syncthreads();
        {
            bf16x8 vf[2];
#pragma unroll
            for (int ks = 0; ks < 2; ++ks) vf[ks] = *(const bf16x8*)(lds + CH_VT + (16 * w + fr) * 144 + (32 * ks + 8 * fq) * 2);
            bf16x8 sb[4];
#pragma unroll
            for (int ks = 0; ks < 4; ++ks) { u32x4 pp; pp.x = pk2(Sacc[2 * ks][0], Sacc[2 * ks][1]); pp.y = pk2(Sacc[2 * ks][2], Sacc[2 * ks][3]);
                pp.z = pk2(Sacc[2 * ks + 1][0], Sacc[2 * ks + 1][1]); pp.w = pk2(Sacc[2 * ks + 1][2], Sacc[2 * ks + 1][3]); sb[ks] = __builtin_bit_cast(bf16x8, pp); }
#pragma unroll
            for (int mb = 0; mb < 4; ++mb) { f32x4 o = (f32x4){0.f, 0.f, 0.f, 0.f};
#pragma unroll
                for (int ks = 0; ks < 2; ++ks) { const bf16x8 af = *(const bf16x8*)(lds + CH_AM + (16 * mb + fr) * 144 + (32 * ks + 8 * fq) * 2); o = mfma16(af, vf[ks], o); }
#pragma unroll
                for (int ks = 0; ks < 4; ++ks) { const unsigned char* qp = lds + CH_QH + (16 * mb + fr) * 272 + (32 * ks + 4 * fq) * 2;
                    const s16x4 lo = *(const s16x4*)qp, hi = *(const s16x4*)(qp + 32); const bf16x8 af = __builtin_shufflevector(lo, hi, 0, 1, 2, 3, 4, 5, 6, 7); o = mfma16(af, sb[ks], o); }
#pragma unroll
                for (int r = 0; r < 4; ++r) OB[(16 * mb + 4 * fq + r) * 132 + 16 * w + fr] = o[r];
            }
#pragma unroll
            for (int mb = 0; mb < 8; ++mb) { const f32x4 d = *(const f32x4*)(DEC + 16 * mb + 4 * fq); Sacc[mb] = Sacc[mb] * d;
#pragma unroll
                for (int ks = 0; ks < 2; ++ks) { const bf16x8 af = *(const bf16x8*)(lds + CH_KHT + (16 * mb + fr) * 144 + (32 * ks + 8 * fq) * 2); Sacc[mb] = mfma16(af, vf[ks], Sacc[mb]); } }
        }
        __syncthreads();
        {
            const int t = tid >> 3, dc = tid & 7; float o[16];
#pragma unroll
            for (int i = 0; i < 4; ++i) { const f32x4 x = *(const f32x4*)(OB + t * 132 + 16 * dc + 4 * i); o[4 * i] = x.x; o[4 * i + 1] = x.y; o[4 * i + 2] = x.z; o[4 * i + 3] = x.w; }
            const size_t row = (size_t)(t0 + t);
            if (MODE == 1) {
                float f[8]; unpack8(*(const u32x4*)(lds + CH_AM + t * 144 + dc * 16), f);
                float rsum = 0.f;
#pragma unroll
                for (int i = 0; i < 8; ++i) rsum += f[i];
                float qn = 0.f; const float* nv = NV + (cc & 1) * 128 + 16 * dc;
                float qf8[8]; unpack8(*(const u32x4*)(lds + CH_QT + t * 272 + dc * 32), qf8);
#pragma unroll
                for (int i = 0; i < 8; ++i) qn += qf8[i] * nv[i];
                unpack8(*(const u32x4*)(lds + CH_QT + t * 272 + dc * 32 + 16), qf8);
#pragma unroll
                for (int i = 0; i < 8; ++i) qn += qf8[i] * nv[8 + i];
                rsum += __shfl_xor(rsum, 1); rsum += __shfl_xor(rsum, 2); rsum += __shfl_xor(rsum, 4);
                qn += __shfl_xor(qn, 1); qn += __shfl_xor(qn, 2); qn += __shfl_xor(qn, 4);
                const float nq = rsum + SCWI[t] * qn; const float den = 1.f / fmaxf(fabsf(nq), SCE[t]);
                const bf16_t* ogp = (const bf16_t*)(ws + WS_OG) + row * 512 + h * 128 + 16 * dc; float og[16];
                unpack8(*(const u32x4*)ogp, og); unpack8(*(const u32x4*)(ogp + 8), og + 8);
#pragma unroll
                for (int i = 0; i < 16; ++i) o[i] = o[i] * den * og[i];
            }
            float ss = 0.f;
#pragma unroll
            for (int i = 0; i < 16; ++i) ss += o[i] * o[i];
            ss += __shfl_xor(ss, 1); ss += __shfl_xor(ss, 2); ss += __shfl_xor(ss, 4);
            const float rn = rsqrtf(ss * (1.f / 128.f) + EPS);
            const float* g = (MODE == 0 ? P.in[7] : P.in[13]) + layer * 128 + 16 * dc;
            bf16_t* yp = Y + row * DMIX + (MODE == 0 ? 0 : 1024) + h * 128 + 16 * dc; float gt[16];
            unpack8(*(const u32x4*)yp, gt); unpack8(*(const u32x4*)(yp + 8), gt + 8);
#pragma unroll
            for (int i = 0; i < 16; ++i) o[i] = o[i] * rn * g[i] * gt[i];
            *(u32x4*)yp = pack8(o); *(u32x4*)(yp + 8) = pack8(o + 8);
        }
        __syncthreads();
    }
}

#ifdef DIS_C0
#define ENA_C0(x)
#else
#define ENA_C0(x) x
#endif
#ifdef DIS_C1
#define ENA_C1(x)
#else
#define ENA_C1(x) x
#endif
#ifdef DIS_A2
#define ENA_A2(x)
#else
#define ENA_A2(x) x
#endif
#ifdef DIS_A1
#define ENA_A1(x)
#else
#define ENA_A1(x) x
#endif
#ifndef PROBE_SEL
#define PROBE_SEL 0
#endif
#if PROBE_SEL
#define STAMP(i) do { const unsigned long long n_ = wall_clock64(); tacc##i += n_ - tprev; tprev = n_; } while (0)
#else
#define STAMP(i) do {} while (0)
#endif
__global__ void __launch_bounds__(NTHR, 2) hymba_fwd(Params P) {
    extern __shared__ __attribute__((aligned(16))) unsigned char lds[];
    cg::grid_group grid = cg::this_grid();
    const int tid = opaque((int)threadIdx.x), bid = blockIdx.x, G = gridDim.x;
    unsigned char* ws = P.ws;
    unsigned* CTL = (unsigned*)(ws + WS_CTL);
    volatile int* s_unit = (volatile int*)(lds + LDS_UNIT_OFF);

#if PROBE_SEL
    unsigned long long tprev = wall_clock64(); const unsigned long long tstart = tprev; unsigned long long tacc0 = 0, tacc1 = 0, tacc2 = 0, tacc3 = 0, tacc4 = 0;
#endif
    phase0(P, lds);
    for (int b = 0; b < NBATCH; ++b) {
        for (int l = 0; l < 2; ++l) {
            const float* xold = (l == 0 ? P.in[0] : (const float*)P.out) + (size_t)b * MP * DM;
            prep_rows(P, xold, l);
            grid.sync(); STAMP(0);
            {
                const int nt_in = (MP / 128) * (NIN / 128);
                const int nt_kv = (b == 0 && l == 0) ? 2 * 4 * 8 : 0;
                for (int tile = bid; tile < nt_in + nt_kv; tile += G) {
                    if (tile < nt_in) { const int tm = tile / (NIN / 128), tn = tile % (NIN / 128);
                        gemm_tile((const bf16_t*)(ws + WS_XB), DM, (const bf16_t*)(ws + WS_WIN) + (size_t)l * NIN * DM, DM, DM, tm * 128, tn * 128, lds);
                        epi_inproj(P, (const float*)lds, tm * 128, tn * 128, l, b);
                    } else { int r = tile - nt_in; const int ll = r / 32; r -= ll * 32; const int tm = r / 8, tn = r % 8;
                        gemm_tile((const bf16_t*)(ws + WS_MNB), DM, (const bf16_t*)(ws + WS_WKV) + (size_t)ll * DM * DM, DM, DM, tm * 128, tn * 128, lds);
                        epi_kvmem(P, (const float*)lds, tm * 128, tn * 128, ll);
                    }
                    __syncthreads();
                }
            }
            grid.sync(); STAMP(1);
            {
                unsigned* ctr = CTL + 16 * (b * 2 + l);
#if PROBE_SEL
                const unsigned long long tq0 = wall_clock64();
#endif
                if (bid < 128) {
                    const int md = bid >> 6, hh = (bid >> 4) & 3, sg = bid & 15;
                    unsigned* fl = CTL + 128 + ((b * 2 + l) * 2 + md) * 64 + hh * 16;
                    if (md == 0) { ENA_C0(chain_unit<0>(P, lds, l, b, hh, sg, fl)); }
                    else { ENA_C1(chain_unit<1>(P, lds, l, b, hh, sg, fl)); }
#if PROBE_SEL
                    if (bid == ((PROBE_SEL == 6) ? 127 : 63)) tacc4 += wall_clock64() - tq0;
#endif
                }
                for (;;) {
                    if (tid == 0) *s_unit = (int)atomicAdd(ctr, 1u);
                    __syncthreads();
                    const int u = __builtin_amdgcn_readfirstlane(*s_unit);
                    __syncthreads();
                    if (u >= 512 + 256) break;
                    if (u < 512) { ENA_A2(attn_unit<2>(P, lds, l, b, u & 3, 127 - (u >> 2))); }
                    else { const int i = u - 512; ENA_A1(attn_unit<1>(P, lds, l, b, i & 3, i >> 2)); }
                }
#if PROBE_SEL
                if (bid == 200) tacc4 += wall_clock64() - tq0;
#endif
            }
            grid.sync(); STAMP(2);
            {
                const int nt = (MP / 128) * (DM / 128);
                for (int tile = bid; tile < nt; tile += G) { const int tm = tile / 8, tn = tile % 8;
                    gemm_tile((const bf16_t*)(ws + WS_Y), DMIX, (const bf16_t*)(ws + WS_WOUT) + (size_t)l * DM * DMIX, DMIX, DMIX, tm * 128, tn * 128, lds);
                    epi_outproj((const float*)lds, xold, P.out + (size_t)b * MP * DM, tm * 128, tn * 128);
                    __syncthreads();
                }
            }
            grid.sync(); STAMP(3);
        }
    }
#if PROBE_SEL
    if (bid == ((PROBE_SEL == 7) ? 200 : (PROBE_SEL == 6) ? 127 : (PROBE_SEL == 5) ? 63 : 0) && tid == 0) {
        unsigned long long sel = (PROBE_SEL == 1) ? tacc0 : (PROBE_SEL == 2) ? tacc1 : (PROBE_SEL == 3) ? tacc2 : (PROBE_SEL == 4) ? tacc3 : tacc4;
        if (sel > 10000000ull) sel = 10000000ull;
        const unsigned long long target = 5000000ull + sel;
        while (wall_clock64() - tstart < target) __builtin_amdgcn_s_sleep(32);
    }
#endif
}

extern "C" void kernel_launch(void* const* d_in, const int* in_sizes, int n_in, void* d_out, int out_size, void* d_ws, size_t ws_size, hipStream_t stream) {
    static int grid = 0;
    if (grid == 0) {
        if (n_in != 18 || ws_size < WS_END) { fprintf(stderr, "kernel_launch: unexpected n_in %d or ws_size %zu < %zu\n", n_in, ws_size, (size_t)WS_END); grid = -1; return; }
        int dev = 0, cus = 0, per_cu = 0;
        hipGetDevice(&dev);
        hipDeviceGetAttribute(&cus, hipDeviceAttributeMultiprocessorCount, dev);
        hipFuncSetAttribute((const void*)hymba_fwd, hipFuncAttributeMaxDynamicSharedMemorySize, LDS_BYTES);
        hipOccupancyMaxActiveBlocksPerMultiprocessor(&per_cu, (const void*)hymba_fwd, NTHR, LDS_BYTES);
        if (per_cu < 1) per_cu = 1;
        grid = cus * per_cu;
    }
    if (grid < 0) return;
    Params p{};
    for (int i = 0; i < 18; ++i) p.in[i] = (const float*)d_in[i];
    p.out = (float*)d_out; p.ws = (unsigned char*)d_ws;
    for (int j = 0; j < 8; ++j) p.inv_freq[j] = (float)pow(500000.0, -(double)(2 * j) / 16.0);
    p.mode = 0; p.pad = 0;
    void* args[] = {&p};
    hipError_t e = hipLaunchCooperativeKernel((const void*)hymba_fwd, dim3(grid), dim3(NTHR), args, LDS_BYTES, stream);
    if (e != hipSuccess) fprintf(stderr, "cooperative launch failed: %s (grid %d)\n", hipGetErrorString(e), grid);
}
```

```cpp
#include <hip/hip_runtime.h>
#include <hip/hip_cooperative_groups.h>
#include <cstdio>
#include <cstdint>
#include <cmath>
namespace cg = cooperative_groups;

#define DI __device__ __forceinline__
typedef unsigned short bf16_t;
typedef short bf16x8 __attribute__((ext_vector_type(8)));
typedef short s16x4 __attribute__((ext_vector_type(4)));
typedef float f32x2 __attribute__((ext_vector_type(2)));
typedef float f32x4 __attribute__((ext_vector_type(4)));
typedef float f32x16 __attribute__((ext_vector_type(16)));
typedef __bf16 bf16x2v __attribute__((ext_vector_type(2)));
typedef unsigned u32x2 __attribute__((ext_vector_type(2)));
typedef unsigned u32x4 __attribute__((ext_vector_type(4)));

constexpr int SEQ = 16384, DM = 1024, NBATCH = 2, MP = 16384;
constexpr int NIN = 7680, NINO = 7688, DMIX = 2048;
constexpr int NTHR = 512;
constexpr float EPS = 1e-6f;
constexpr int LDS_BYTES = 143360;
constexpr int LDS_UNIT_OFF = 143344;

constexpr size_t WS_CTL   = 0;
constexpr size_t WS_WIN   = 4096;
constexpr size_t WS_WOUT  = WS_WIN  + (size_t)2 * NIN * DM * 2;
constexpr size_t WS_WKV   = WS_WOUT + (size_t)2 * DM * DMIX * 2;
constexpr size_t WS_MNB   = WS_WKV  + (size_t)2 * DM * DM * 2;
constexpr size_t WS_KMB   = WS_MNB  + (size_t)512 * DM * 2;
constexpr size_t WS_VMT   = WS_KMB  + (size_t)2 * 512 * 512 * 2;
constexpr size_t WS_COS   = WS_VMT  + (size_t)2 * 2 * 512 * 256 * 2;
constexpr size_t WS_SIN   = WS_COS  + (size_t)32768 * 8 * 4;
constexpr size_t WS_LB    = WS_SIN  + (size_t)32768 * 8 * 4;
constexpr size_t WS_XB    = WS_LB   + 4096;
constexpr size_t WS_RSTD  = WS_XB   + (size_t)MP * DM * 2;
constexpr size_t WS_GATES = WS_RSTD + (size_t)MP * 4;
constexpr size_t SZ512    = (size_t)MP * 512 * 2;
constexpr size_t WS_QA    = WS_GATES + (size_t)MP * 8 * 4;
constexpr size_t WS_LF    = WS_QA + SZ512;
constexpr size_t WS_VAT   = WS_LF + SZ512;
constexpr size_t WS_QB    = WS_VAT + SZ512;
constexpr size_t WS_KB    = WS_QB + SZ512;
constexpr size_t WS_VBT   = WS_KB + SZ512;
constexpr size_t WS_CQ    = WS_VBT + SZ512;
constexpr size_t WS_CK    = WS_CQ + SZ512;
constexpr size_t WS_CVT   = WS_CK + SZ512;
constexpr size_t WS_OG    = WS_CVT + SZ512;
constexpr size_t WS_QX    = WS_OG + SZ512;
constexpr size_t WS_Y     = WS_QX + SZ512;
constexpr size_t WS_STATE = WS_Y + (size_t)MP * DMIX * 2;
constexpr size_t WS_END   = WS_STATE + (size_t)2 * 4 * 16 * (16384 + 128) * 4;

struct Params {
    const float* in[18];
    float* out;
    unsigned char* ws;
    float inv_freq[8];
    int mode;
    int pad;
};

DI float bf2f(bf16_t v) { return __uint_as_float(((unsigned)v) << 16); }
DI unsigned pk2(float lo, float hi) { f32x2 v = {lo, hi}; bf16x2v b = __builtin_convertvector(v, bf16x2v); return __builtin_bit_cast(unsigned, b); }
DI bf16_t f2bf(float x) { return (bf16_t)(pk2(x, 0.f) & 0xffffu); }
DI float wave_sum(float v) {
#pragma unroll
    for (int o = 1; o < 64; o <<= 1) v += __shfl_xor(v, o);
    return v;
}
DI float sigmoidf_(float x) { return 1.f / (1.f + __expf(-x)); }
DI float siluf_(float x) { return x / (1.f + __expf(-x)); }
DI f32x4 mfma16(bf16x8 a, bf16x8 b, f32x4 c) { return __builtin_amdgcn_mfma_f32_16x16x32_bf16(a, b, c, 0, 0, 0); }
DI f32x16 mfma32(bf16x8 a, bf16x8 b, f32x16 c) { return __builtin_amdgcn_mfma_f32_32x32x16_bf16(a, b, c, 0, 0, 0); }
DI int opaque(int x) { asm volatile("" : "+v"(x)); return x; }
DI int crow(int r, int h2) { return (r & 3) + 8 * (r >> 2) + 4 * h2; }
DI void unpack8(u32x4 u, float* f) {
    f[0] = __uint_as_float(u.x << 16); f[1] = __uint_as_float(u.x & 0xffff0000u);
    f[2] = __uint_as_float(u.y << 16); f[3] = __uint_as_float(u.y & 0xffff0000u);
    f[4] = __uint_as_float(u.z << 16); f[5] = __uint_as_float(u.z & 0xffff0000u);
    f[6] = __uint_as_float(u.w << 16); f[7] = __uint_as_float(u.w & 0xffff0000u);
}
DI u32x4 pack8(const float* f) { u32x4 o; o.x = pk2(f[0], f[1]); o.y = pk2(f[2], f[3]); o.z = pk2(f[4], f[5]); o.w = pk2(f[6], f[7]); return o; }

DI void transpose_tile(const float* src, int ldsrc, int srccol0, const float* g, bf16_t* dst, int lddst, int k0, int n0, float* T, int tid) {
    const int n = tid & 63, kk = tid >> 6;
#pragma unroll
    for (int i = 0; i < 8; ++i) { const int k = kk + 8 * i; float v = src[(size_t)(k0 + k) * ldsrc + srccol0 + n]; if (g) v *= g[k0 + k]; T[k * 65 + n] = v; }
    __syncthreads();
    const int nn = tid >> 3, kc = tid & 7;
    float f[8];
#pragma unroll
    for (int i = 0; i < 8; ++i) f[i] = T[(8 * kc + i) * 65 + nn];
    *(u32x4*)(dst + (size_t)(n0 + nn) * lddst + k0 + 8 * kc) = pack8(f);
    __syncthreads();
}

DI void phase0(const Params& P, unsigned char* lds) {
    const int tid = opaque((int)threadIdx.x), bid = blockIdx.x, G = gridDim.x;
    unsigned char* ws = P.ws;
    float* T = (float*)lds;
    if (bid == 0) { for (int i = tid; i < 1024; i += NTHR) ((unsigned*)(ws + WS_CTL))[i] = 0u; }
    constexpr int T_IN = 16 * 120, T_OUT = 32 * 16, T_KV = 16 * 16;
    constexpr int NT = 2 * (T_IN + T_OUT + T_KV);
    for (int it = bid; it < NT; it += G) {
        int r = it; const int l = r / (T_IN + T_OUT + T_KV); r -= l * (T_IN + T_OUT + T_KV);
        if (r < T_IN) { const int kb = r / 120, nb = r % 120, n0 = nb * 64; const int sc = n0 < 6144 ? n0 : n0 + 8;
            transpose_tile(P.in[4] + (size_t)l * DM * NINO, NINO, sc, P.in[3] + l * DM, (bf16_t*)(ws + WS_WIN) + (size_t)l * NIN * DM, DM, kb * 64, n0, T, tid); continue; }
        r -= T_IN;
        if (r < T_OUT) { const int kb = r / 16, nb = r % 16;
            transpose_tile(P.in[17] + (size_t)l * DMIX * DM, DM, nb * 64, nullptr, (bf16_t*)(ws + WS_WOUT) + (size_t)l * DM * DMIX, DMIX, kb * 64, nb * 64, T, tid); continue; }
        r -= T_OUT;
        { const int kb = r / 16, nb = r % 16;
            transpose_tile(P.in[15] + (size_t)l * DM * DM, DM, nb * 64, P.in[14] + l * DM, (bf16_t*)(ws + WS_WKV) + (size_t)l * DM * DM, DM, kb * 64, nb * 64, T, tid); }
    }
    const int gt = bid * NTHR + tid, NG = G * NTHR;
    {
        const int* pos = (const int*)P.in[2];
        float* C = (float*)(ws + WS_COS); float* Sn = (float*)(ws + WS_SIN);
        for (int i = gt; i < 32768 * 8; i += NG) { const int row = i >> 3, j = i & 7; const float ang = (float)pos[row] * P.inv_freq[j]; C[i] = cosf(ang); Sn[i] = sinf(ang); }
    }
    { float* LB = (float*)(ws + WS_LB); const float* lg = P.in[6];
      for (int i = gt; i < 512; i += NG) { LB[i] = 0.f; LB[512 + i] = 1.f / (1.f + expf(lg[i] - lg[512 + i])); } }
    { const int lane = tid & 63, gw = (bid * NTHR + tid) >> 6, NGW = (G * NTHR) >> 6;
      for (int r = gw; r < 512; r += NGW) {
          const f32x4* xr = (const f32x4*)(P.in[1] + (size_t)r * DM) + lane; f32x4 v[4]; float s = 0.f;
#pragma unroll
          for (int j = 0; j < 4; ++j) { v[j] = xr[64 * j]; s += v[j].x * v[j].x + v[j].y * v[j].y + v[j].z * v[j].z + v[j].w * v[j].w; }
          const float rs = rsqrtf(wave_sum(s) * (1.f / DM) + EPS);
          u32x2* o = (u32x2*)((bf16_t*)(ws + WS_MNB) + (size_t)r * DM) + lane;
#pragma unroll
          for (int j = 0; j < 4; ++j) { u32x2 w; w.x = pk2(v[j].x * rs, v[j].y * rs); w.y = pk2(v[j].z * rs, v[j].w * rs); o[64 * j] = w; }
      } }
}

DI void prep_rows(const Params& P, const float* xsrc, int layer) {
    const int tid = opaque((int)threadIdx.x), lane = tid & 63, gw = (blockIdx.x * NTHR + tid) >> 6, NGW = (gridDim.x * NTHR) >> 6;
    unsigned char* ws = P.ws;
    const float* win = P.in[4] + (size_t)layer * DM * NINO; const float* ng = P.in[3] + layer * DM; const float* gb = P.in[5] + layer * 8;
    bf16_t* XB = (bf16_t*)(ws + WS_XB); float* RSTD = (float*)(ws + WS_RSTD); float* GATES = (float*)(ws + WS_GATES);
    for (int r = gw; r < MP; r += NGW) {
        const f32x4* xr = (const f32x4*)(xsrc + (size_t)r * DM) + lane; f32x4 v[4]; float s = 0.f;
#pragma unroll
        for (int j = 0; j < 4; ++j) { v[j] = xr[64 * j]; s += v[j].x * v[j].x + v[j].y * v[j].y + v[j].z * v[j].z + v[j].w * v[j].w; }
        const float rs = rsqrtf(wave_sum(s) * (1.f / DM) + EPS);
        u32x2* o = (u32x2*)(XB + (size_t)r * DM) + lane;
#pragma unroll
        for (int j = 0; j < 4; ++j) { u32x2 w; w.x = pk2(v[j].x, v[j].y); w.y = pk2(v[j].z, v[j].w); o[64 * j] = w; }
        float d[8];
#pragma unroll
        for (int g = 0; g < 8; ++g) d[g] = 0.f;
#pragma unroll
        for (int j = 0; j < 4; ++j) {
#pragma unroll
            for (int e = 0; e < 4; ++e) { const int k = 4 * lane + 256 * j + e; const float xv = v[j][e] * ng[k];
                const f32x4 w0 = *(const f32x4*)(win + (size_t)k * NINO + 6144); const f32x4 w1 = *(const f32x4*)(win + (size_t)k * NINO + 6148);
                d[0] += xv * w0.x; d[1] += xv * w0.y; d[2] += xv * w0.z; d[3] += xv * w0.w; d[4] += xv * w1.x; d[5] += xv * w1.y; d[6] += xv * w1.z; d[7] += xv * w1.w; }
        }
#pragma unroll
        for (int g = 0; g < 8; ++g) d[g] = wave_sum(d[g]) * rs;
        if (lane == 0) {
            RSTD[r] = rs;
            f32x4 gi, gf;
#pragma unroll
            for (int g = 0; g < 4; ++g) { gi[g] = d[g] + gb[g]; const float z = d[4 + g] + gb[4 + g]; gf[g] = fminf(z, 0.f) - log1pf(expf(-fabsf(z))); }
            *(f32x4*)(GATES + (size_t)r * 8) = gi; *(f32x4*)(GATES + (size_t)r * 8 + 4) = gf;
        }
    }
}

template <class Epi>
DI void gemm_tile(const bf16_t* A, int lda, const bf16_t* Bt, int ldb, int K, int row0, int col0, unsigned char* lds, const Epi& epi) {
    const int tid = opaque((int)threadIdx.x), lane = tid & 63, w = __builtin_amdgcn_readfirstlane(tid >> 6), wr = w >> 1, wc = w & 1, fr = lane & 15, fq = lane >> 4;
    constexpr int STG = 49152;
    f32x4 acc[4][4];
#pragma unroll
    for (int m = 0; m < 4; ++m)
#pragma unroll
        for (int n = 0; n < 4; ++n) acc[m][n] = (f32x4){0.f, 0.f, 0.f, 0.f};
    u32x4 ra[4], rb[2];
    const int nt = K / 64;
    const int sc = tid & 7, sr0 = tid >> 3;
    const bf16_t* Ap = A + (size_t)(row0 + sr0) * lda + sc * 8;
    const bf16_t* Bp = Bt + (size_t)(col0 + sr0) * ldb + sc * 8;
    const int so = sr0 * 128 + ((sc ^ (sr0 & 7)) << 4);
#pragma unroll
    for (int i = 0; i < 4; ++i) ra[i] = *(const u32x4*)(Ap + (size_t)(64 * i) * lda);
#pragma unroll
    for (int i = 0; i < 2; ++i) rb[i] = *(const u32x4*)(Bp + (size_t)(64 * i) * ldb);
#pragma unroll
    for (int i = 0; i < 4; ++i) *(u32x4*)(lds + so + i * 8192) = ra[i];
#pragma unroll
    for (int i = 0; i < 2; ++i) *(u32x4*)(lds + 32768 + so + i * 8192) = rb[i];
    __syncthreads();
    for (int t = 0; t < nt; ++t) {
        const unsigned char* LA = lds + (t & 1) * STG; const unsigned char* LB = LA + 32768;
        if (t + 1 < nt) {
#pragma unroll
            for (int i = 0; i < 4; ++i) ra[i] = *(const u32x4*)(Ap + (size_t)(64 * i) * lda + (t + 1) * 64);
#pragma unroll
            for (int i = 0; i < 2; ++i) rb[i] = *(const u32x4*)(Bp + (size_t)(64 * i) * ldb + (t + 1) * 64);
        }
#pragma unroll
        for (int kk = 0; kk < 2; ++kk) {
            bf16x8 af[4], bfr[4]; const int ch = kk * 4 + fq;
#pragma unroll
            for (int m = 0; m < 4; ++m) { const int r = wr * 64 + m * 16 + fr; af[m] = *(const bf16x8*)(LA + r * 128 + ((ch ^ (r & 7)) << 4)); }
#pragma unroll
            for (int n = 0; n < 4; ++n) { const int r = wc * 64 + n * 16 + fr; bfr[n] = *(const bf16x8*)(LB + r * 128 + ((ch ^ (r & 7)) << 4)); }
#pragma unroll
            for (int m = 0; m < 4; ++m)
#pragma unroll
                for (int n = 0; n < 4; ++n) acc[m][n] = mfma16(af[m], bfr[n], acc[m][n]);
        }
        if (t + 1 < nt) {
            unsigned char* NA = lds + ((t + 1) & 1) * STG;
#pragma unroll
            for (int i = 0; i < 4; ++i) *(u32x4*)(NA + so + i * 8192) = ra[i];
#pragma unroll
            for (int i = 0; i < 2; ++i) *(u32x4*)(NA + 32768 + so + i * 8192) = rb[i];
        }
        __syncthreads();
    }
    float* T = (float*)lds;
#pragma unroll
    for (int hf = 0; hf < 2; ++hf) {
        if ((wr >> 1) == hf) {
#pragma unroll
            for (int m = 0; m < 4; ++m)
#pragma unroll
                for (int n = 0; n < 4; ++n)
#pragma unroll
                    for (int r = 0; r < 4; ++r) T[((wr & 1) * 64 + m * 16 + 4 * fq + r) * 132 + wc * 64 + n * 16 + fr] = acc[m][n][r];
        }
        __syncthreads();
        epi(T, row0 + hf * 128, col0);
        __syncthreads();
    }
}

DI void epi_inproj(const Params& P, const float* T, int row0, int col0, int layer, int batch) {
    const int tid = opaque((int)threadIdx.x); unsigned char* ws = P.ws;
    const int seg = col0 >> 9, cseg = col0 & 511;
    const float* RSTD = (const float*)(ws + WS_RSTD);
    const bool transposed = (seg == 2 || seg == 6 || seg == 10);
    if (transposed) {
        bf16_t* dst = (bf16_t*)(ws + (seg == 2 ? WS_VAT : (seg == 6 ? WS_VBT : WS_CVT)));
#pragma unroll
        for (int j = 0; j < 4; ++j) { const int item = tid + NTHR * j, rc = item & 15, col = item >> 4; float f[8];
#pragma unroll
            for (int i = 0; i < 8; ++i) f[i] = T[(rc * 8 + i) * 132 + col] * RSTD[row0 + rc * 8 + i];
            *(u32x4*)(dst + (size_t)(cseg + col) * MP + row0 + rc * 8) = pack8(f); }
        return;
    }
    const float* LB = (const float*)(ws + WS_LB) + layer * 512;
    const float* COSt = (const float*)(ws + WS_COS); const float* SINt = (const float*)(ws + WS_SIN);
#pragma unroll
    for (int j = 0; j < 4; ++j) {
        const int item = tid + NTHR * j, r = item >> 4, ch = item & 15, row = row0 + r, c = cseg + ch * 8;
        const float rs = RSTD[row]; float v[8];
        { const f32x4 a = *(const f32x4*)(T + r * 132 + ch * 8), b = *(const f32x4*)(T + r * 132 + ch * 8 + 4);
          v[0] = a.x * rs; v[1] = a.y * rs; v[2] = a.z * rs; v[3] = a.w * rs; v[4] = b.x * rs; v[5] = b.y * rs; v[6] = b.z * rs; v[7] = b.w * rs; }
        bf16_t* dst = nullptr; size_t doff = (size_t)row * 512 + c;
        switch (seg) {
        case 0: { dst = (bf16_t*)(ws + WS_QA);
#pragma unroll
            for (int i = 0; i < 8; ++i) v[i] = siluf_(v[i]) * 0.08838834764831845f; } break;
        case 1: { dst = (bf16_t*)(ws + WS_LF);
#pragma unroll
            for (int i = 0; i < 8; ++i) { const float lb = LB[c + i]; v[i] = logf(fmaxf(lb + (1.f - lb) * sigmoidf_(v[i]), 1e-30f)); } } break;
        case 3: case 7: case 12: case 14: { dst = (bf16_t*)(ws + WS_Y); doff = (size_t)row * DMIX + (seg == 3 ? 0 : (seg == 7 ? 512 : (seg == 12 ? 1024 : 1536))) + c;
#pragma unroll
            for (int i = 0; i < 8; ++i) v[i] = siluf_(v[i]); } break;
        case 4: case 5: {
            dst = (bf16_t*)(ws + (seg == 4 ? WS_QB : WS_KB));
            float ss = 0.f;
#pragma unroll
            for (int i = 0; i < 8; ++i) ss += v[i] * v[i];
            ss += __shfl_xor(ss, 1); ss += __shfl_xor(ss, 2); ss += __shfl_xor(ss, 4);
            const float rn = rsqrtf(ss * (1.f / 64.f) + EPS);
            const float* g = P.in[8] + layer * 128 + (seg == 4 ? 0 : 64) + (ch & 7) * 8;
            const int grow = batch * SEQ + row; const int c7 = ch & 7;
            const float sc = (seg == 4) ? 0.125f : 1.f;
#pragma unroll
            for (int i = 0; i < 8; ++i) {
                float y = v[i] * rn * g[i];
                const float part = __shfl_xor(y, 1);
                const float cs = COSt[grow * 8 + i], sn = SINt[grow * 8 + i];
                if (c7 == 0) y = y * cs - part * sn; else if (c7 == 1) y = y * cs + part * sn;
                v[i] = y * sc;
            } } break;
        case 8: dst = (bf16_t*)(ws + WS_CQ); break;
        case 9: dst = (bf16_t*)(ws + WS_CK); break;
        case 11: { dst = (bf16_t*)(ws + WS_OG);
#pragma unroll
            for (int i = 0; i < 8; ++i) v[i] = sigmoidf_(v[i]); } break;
        case 13: { dst = (bf16_t*)(ws + WS_QX);
            float ss = 0.f;
#pragma unroll
            for (int i = 0; i < 8; ++i) ss += v[i] * v[i];
            ss += __shfl_xor(ss, 1); ss += __shfl_xor(ss, 2); ss += __shfl_xor(ss, 4); ss += __shfl_xor(ss, 8);
            const float rn = rsqrtf(ss * (1.f / 128.f) + EPS) * 0.08838834764831845f;
            const float* g = P.in[16] + layer * 256 + ch * 8;
#pragma unroll
            for (int i = 0; i < 8; ++i) v[i] = v[i] * rn * g[i]; } break;
        default: break;
        }
        *(u32x4*)(dst + doff) = pack8(v);
    }
}

DI void epi_kvmem(const Params& P, const float* T, int row0, int col0, int layer) {
    const int tid = opaque((int)threadIdx.x); unsigned char* ws = P.ws;
    if (col0 < 512) {
        bf16_t* dst = (bf16_t*)(ws + WS_KMB) + (size_t)layer * 512 * 512;
        const float* g = P.in[16] + layer * 256 + 128;
#pragma unroll
        for (int j = 0; j < 4; ++j) { const int item = tid + NTHR * j, r = item >> 4, ch = item & 15; float v[8];
            { const f32x4 a = *(const f32x4*)(T + r * 132 + ch * 8), b = *(const f32x4*)(T + r * 132 + ch * 8 + 4);
              v[0] = a.x; v[1] = a.y; v[2] = a.z; v[3] = a.w; v[4] = b.x; v[5] = b.y; v[6] = b.z; v[7] = b.w; }
            float ss = 0.f;
#pragma unroll
            for (int i = 0; i < 8; ++i) ss += v[i] * v[i];
            ss += __shfl_xor(ss, 1); ss += __shfl_xor(ss, 2); ss += __shfl_xor(ss, 4); ss += __shfl_xor(ss, 8);
            const float rn = rsqrtf(ss * (1.f / 128.f) + EPS);
#pragma unroll
            for (int i = 0; i < 8; ++i) v[i] = v[i] * rn * g[ch * 8 + i];
            *(u32x4*)(dst + (size_t)(row0 + r) * 512 + col0 + ch * 8) = pack8(v); }
    } else {
        const int b = row0 >> 8, m0 = row0 & 255;
        bf16_t* dst = (bf16_t*)(ws + WS_VMT) + (size_t)(layer * 2 + b) * 512 * 256;
#pragma unroll
        for (int j = 0; j < 4; ++j) { const int item = tid + NTHR * j, rc = item & 15, col = item >> 4; float f[8];
#pragma unroll
            for (int i = 0; i < 8; ++i) f[i] = T[(rc * 8 + i) * 132 + col];
            *(u32x4*)(dst + (size_t)(col0 - 512 + col) * 256 + m0 + rc * 8) = pack8(f); }
    }
}

DI void epi_outproj(const float* T, const float* xold, float* out, int grow0, int col0) {
    const int tid = opaque((int)threadIdx.x);
#pragma unroll
    for (int j = 0; j < 8; ++j) { const int item = tid + NTHR * j, r = item >> 5, c4 = item & 31;
        const size_t off = (size_t)(grow0 + r) * DM + col0 + c4 * 4;
        const f32x4 a = *(const f32x4*)(T + r * 132 + c4 * 4), x = *(const f32x4*)(xold + off);
        *(f32x4*)(out + off) = a + x; }
}

template <int NCOMP>
DI void attn_unit(const Params& P, unsigned char* lds, int layer, int batch, int h, int qb) {
    constexpr int NS = (NCOMP == 2) ? 4 : 8;
    constexpr int STG = 64 * 272 + 128 * 136;
    const int tid = opaque((int)threadIdx.x), lane = tid & 63, w = __builtin_amdgcn_readfirstlane(tid >> 6), l31 = lane & 31, h2 = lane >> 5;
    unsigned char* ws = P.ws;
    const int comp = (NCOMP == 2) ? (w >> 2) : 0;
    const int q0 = (NCOMP == 2) ? qb * 128 : qb * 256;
    const int qw = (NCOMP == 2) ? q0 + 32 * (w & 3) : q0 + 32 * w;
    const bf16_t* Qsrc = (const bf16_t*)(ws + (NCOMP == 2 ? WS_QB : WS_QX));
    const bf16_t* Ksrc; const bf16_t* Vsrc; int ldv, nkt;
    if (NCOMP == 2) { Ksrc = (const bf16_t*)(ws + WS_KB) + h * 128; Vsrc = (const bf16_t*)(ws + WS_VBT) + (size_t)(h * 128) * MP; ldv = MP; nkt = 2 * qb + 2; }
    else { Ksrc = (const bf16_t*)(ws + WS_KMB) + (size_t)layer * 512 * 512 + (size_t)batch * 256 * 512 + h * 128;
           Vsrc = (const bf16_t*)(ws + WS_VMT) + (size_t)(layer * 2 + batch) * 512 * 256 + (size_t)(h * 128) * 256; ldv = 256; nkt = 4; }
    bf16x8 qf[NS];
    { const bf16_t* qp = Qsrc + (size_t)(qw + l31) * 512 + h * 128 + comp * 64 + 8 * h2;
#pragma unroll
      for (int s = 0; s < NS; ++s) qf[s] = *(const bf16x8*)(qp + 16 * s);
      asm volatile("s_waitcnt vmcnt(0)" ::: "memory");
#pragma unroll
      for (int s = 0; s < NS; ++s) asm volatile("" : "+v"(qf[s])); }
    f32x16 O[4];
#pragma unroll
    for (int d = 0; d < 4; ++d)
#pragma unroll
        for (int i = 0; i < 16; ++i) O[d][i] = 0.f;
    float mrun = -1e30f, lsum = 0.f;
    u32x4 rk[2], rv[2]; int kr[2], kc[2], vr[2], vc[2];
#pragma unroll
    for (int i = 0; i < 2; ++i) { const int c = tid + NTHR * i; kr[i] = c >> 4; kc[i] = c & 15; vr[i] = c >> 3; vc[i] = c & 7; }
#pragma unroll
    for (int i = 0; i < 2; ++i) { rk[i] = *(const u32x4*)(Ksrc + (size_t)kr[i] * 512 + kc[i] * 8); rv[i] = *(const u32x4*)(Vsrc + (size_t)vr[i] * ldv + vc[i] * 8); }
#pragma unroll
    for (int i = 0; i < 2; ++i) { *(u32x4*)(lds + kr[i] * 272 + kc[i] * 16) = rk[i];
        unsigned char* vp = lds + 64 * 272 + vr[i] * 136 + vc[i] * 16; *(u32x2*)vp = (u32x2){rv[i].x, rv[i].y}; *(u32x2*)(vp + 8) = (u32x2){rv[i].z, rv[i].w}; }
    __syncthreads();
    for (int kt = 0; kt < nkt; ++kt) {
        const unsigned char* LK = lds + (kt & 1) * STG; const unsigned char* LV = LK + 64 * 272;
        if (kt + 1 < nkt) {
#pragma unroll
            for (int i = 0; i < 2; ++i) { rk[i] = *(const u32x4*)(Ksrc + (size_t)((kt + 1) * 64 + kr[i]) * 512 + kc[i] * 8); rv[i] = *(const u32x4*)(Vsrc + (size_t)vr[i] * ldv + (kt + 1) * 64 + vc[i] * 8); }
        }
        const bool active = (NCOMP == 1) || (kt * 64 <= qw + 31);
        if (active) {
#pragma unroll
            for (int kb = 0; kb < 2; ++kb) {
                f32x16 S;
#pragma unroll
                for (int i = 0; i < 16; ++i) S[i] = 0.f;
#pragma unroll
                for (int s = 0; s < NS; ++s) { const bf16x8 kf = *(const bf16x8*)(LK + (32 * kb + l31) * 272 + comp * 128 + (16 * s + 8 * h2) * 2); S = mfma32(kf, qf[s], S); }
                if (NCOMP == 2 && (kt * 64 + 32 * kb + 31 > qw)) {
                    const int qpos = qw + l31;
#pragma unroll
                    for (int i = 0; i < 16; ++i) { const int key = kt * 64 + 32 * kb + crow(i, h2); if (key > qpos) S[i] = -1e30f; }
                }
                float mx = S[0];
#pragma unroll
                for (int i = 1; i < 16; ++i) mx = fmaxf(mx, S[i]);
                mx = fmaxf(mx, __shfl_xor(mx, 32));
                const float mnew = fmaxf(mrun, mx), alpha = __expf(mrun - mnew);
                mrun = mnew;
                float ps = 0.f;
#pragma unroll
                for (int i = 0; i < 16; ++i) { const float p = __expf(S[i] - mnew); S[i] = p; ps += p; }
                lsum = lsum * alpha + ps;
#pragma unroll
                for (int d = 0; d < 4; ++d)
#pragma unroll
                    for (int i = 0; i < 16; ++i) O[d][i] *= alpha;
#pragma unroll
                for (int s2 = 0; s2 < 2; ++s2) {
                    u32x4 pp; pp.x = pk2(S[8 * s2 + 0], S[8 * s2 + 1]); pp.y = pk2(S[8 * s2 + 2], S[8 * s2 + 3]); pp.z = pk2(S[8 * s2 + 4], S[8 * s2 + 5]); pp.w = pk2(S[8 * s2 + 6], S[8 * s2 + 7]);
                    const bf16x8 pf = __builtin_bit_cast(bf16x8, pp);
#pragma unroll
                    for (int d = 0; d < 4; ++d) {
                        const unsigned char* vp = LV + (32 * d + l31) * 136 + (32 * kb + 16 * s2 + 4 * h2) * 2;
                        const s16x4 lo = *(const s16x4*)vp, hi = *(const s16x4*)(vp + 16);
                        const bf16x8 vf = __builtin_shufflevector(lo, hi, 0, 1, 2, 3, 4, 5, 6, 7);
                        O[d] = mfma32(vf, pf, O[d]);
                    }
                }
            }
        }
        if (kt + 1 < nkt) {
            unsigned char* NK = lds + ((kt + 1) & 1) * STG;
#pragma unroll
            for (int i = 0; i < 2; ++i) { *(u32x4*)(NK + kr[i] * 272 + kc[i] * 16) = rk[i];
                unsigned char* vp = NK + 64 * 272 + vr[i] * 136 + vc[i] * 16; *(u32x2*)vp = (u32x2){rv[i].x, rv[i].y}; *(u32x2*)(vp + 8) = (u32x2){rv[i].z, rv[i].w}; }
        }
        __syncthreads();
    }
    const float inv = 1.f / (lsum + __shfl_xor(lsum, 32));
#pragma unroll
    for (int d = 0; d < 4; ++d)
#pragma unroll
        for (int i = 0; i < 16; ++i) O[d][i] *= inv;
    bf16_t* Y = (bf16_t*)(ws + WS_Y);
    if (NCOMP == 1) {
        bf16_t* yp = Y + (size_t)(qw + l31) * DMIX + 1536 + h * 128;
#pragma unroll
        for (int d = 0; d < 4; ++d)
#pragma unroll
            for (int g = 0; g < 4; ++g) { const int dv = 32 * d + 8 * g + 4 * h2; const u32x2 gt = *(const u32x2*)(yp + dv);
                u32x2 o; o.x = pk2(O[d][4 * g + 0] * __uint_as_float(gt.x << 16), O[d][4 * g + 1] * __uint_as_float(gt.x & 0xffff0000u));
                o.y = pk2(O[d][4 * g + 2] * __uint_as_float(gt.y << 16), O[d][4 * g + 3] * __uint_as_float(gt.y & 0xffff0000u));
                *(u32x2*)(yp + dv) = o; }
        __syncthreads();
        return;
    }
    float* X = (float*)lds;
    const int ql = 32 * (w & 3) + l31;
    if (comp == 1) {
#pragma unroll
        for (int d = 0; d < 4; ++d)
#pragma unroll
            for (int i = 0; i < 16; ++i) X[ql * 132 + 32 * d + crow(i, h2)] = O[d][i];
    }
    __syncthreads();
    const float* lp = P.in[9] + layer * 256;
    float lam;
    { const float a = wave_sum(lp[lane] * lp[64 + lane]), b = wave_sum(lp[128 + lane] * lp[192 + lane]);
      const float lam_init = 0.8f - 0.6f * expf(-0.3f * (float)layer); lam = expf(a) - expf(b) + lam_init; }
    if (comp == 0) {
#pragma unroll
        for (int d = 0; d < 4; ++d)
#pragma unroll
            for (int i = 0; i < 16; ++i) { const int a = ql * 132 + 32 * d + crow(i, h2); X[a] = O[d][i] - lam * X[a]; }
    }
    __syncthreads();
    {
        const float lam_init = 0.8f - 0.6f * expf(-0.3f * (float)layer);
        const float* g = P.in[10] + layer * 128;
#pragma unroll
        for (int j = 0; j < 4; ++j) { const int item = tid + NTHR * j, r = item >> 4, ch = item & 15; float v[8];
            { const f32x4 a = *(const f32x4*)(X + r * 132 + ch * 8), b = *(const f32x4*)(X + r * 132 + ch * 8 + 4);
              v[0] = a.x; v[1] = a.y; v[2] = a.z; v[3] = a.w; v[4] = b.x; v[5] = b.y; v[6] = b.z; v[7] = b.w; }
            float ss = 0.f;
#pragma unroll
            for (int i = 0; i < 8; ++i) ss += v[i] * v[i];
            ss += __shfl_xor(ss, 1); ss += __shfl_xor(ss, 2); ss += __shfl_xor(ss, 4); ss += __shfl_xor(ss, 8);
            const float rn = rsqrtf(ss * (1.f / 128.f) + EPS) * (1.f - lam_init);
            bf16_t* yp = Y + (size_t)(q0 + r) * DMIX + 512 + h * 128 + ch * 8; float gt[8]; unpack8(*(const u32x4*)yp, gt);
#pragma unroll
            for (int i = 0; i < 8; ++i) v[i] = v[i] * rn * g[ch * 8 + i] * gt[i];
            *(u32x4*)yp = pack8(v); }
    }
    __syncthreads();
}

constexpr int NSEG = 16, CPS = 16;
constexpr int SIN_FLOATS = 16384 + 128;
constexpr int CH_QT = 0, CH_KT = 17408, CH_QH = 34816, CH_KHT = 52224, CH_VT = 70656, CH_AM = 89088, CH_OB = 98304, CH_PART = 132096,
              CH_DEC = 134144, CH_NV = 134656  , CH_SC = 135680  , CH_MC = 136704  ,
              CH_DT = 137728  , CH_NL = 138240  ;

template <int MODE, bool FULL>
DI void chain_prep(const Params& P, unsigned char* lds, int layer, int h, int t0, int tid, int lane, int w, int k, int tg, float mcar) {
    unsigned char* ws = P.ws;
    bf16_t* QT = (bf16_t*)(lds + CH_QT); bf16_t* KT = (bf16_t*)(lds + CH_KT); bf16_t* QH = (bf16_t*)(lds + CH_QH);
    float* PART = (float*)(lds + CH_PART); float* DEC = (float*)(lds + CH_DEC);
    float* SCA = (float*)(lds + CH_SC); float* SCM = SCA + 64; float* SCWI = SCA + 128; float* SCE = SCA + 192;
    const bf16_t* Vsrc = (const bf16_t*)(ws + (MODE == 0 ? WS_VAT : WS_CVT)) + (size_t)(h * 128) * MP;
#pragma unroll
    for (int i = 0; i < 2; ++i) { const int c = tid + NTHR * i, dv = c >> 3, ch = c & 7;
        *(u32x4*)(lds + CH_VT + dv * 144 + ch * 16) = *(const u32x4*)(Vsrc + (size_t)dv * MP + t0 + ch * 8); }
    float khv[16];
    if (MODE == 0) {
        const bf16_t* LFp = (const bf16_t*)(ws + WS_LF) + (size_t)(t0 + 16 * tg) * 512 + h * 128 + k;
        const bf16_t* QAp = (const bf16_t*)(ws + WS_QA) + (size_t)(t0 + 16 * tg) * 512 + h * 128 + k;
        float lf[16], q[16]; float part = 0.f;
#pragma unroll
        for (int i = 0; i < 16; ++i) { lf[i] = bf2f(LFp[(size_t)i * 512]); if (FULL) q[i] = bf2f(QAp[(size_t)i * 512]); part += lf[i]; }
        PART[tg * 128 + k] = part;
        __syncthreads();
        const float p0 = PART[k], p1 = PART[128 + k], p2 = PART[256 + k], p3 = PART[384 + k];
        const float bmid = p0 + p1, total = bmid + p2 + p3;
        float run = (tg > 0 ? p0 : 0.f) + (tg > 1 ? p1 : 0.f) + (tg > 2 ? p2 : 0.f);
#pragma unroll
        for (int i = 0; i < 16; ++i) { run += lf[i]; const float f = __expf(lf[i]), kk = 1.f - f; const int t = 16 * tg + i;
            if (FULL) { QT[t * 136 + k] = f2bf(q[i] * __expf(run - bmid)); KT[t * 136 + k] = f2bf(kk * __expf(bmid - run)); QH[t * 136 + k] = f2bf(q[i] * __expf(run)); }
            khv[i] = kk * __expf(total - run); }
        if (tg == 0) DEC[k] = __expf(total);
    } else {
        const float* GT = (const float*)(ws + WS_GATES) + (size_t)(t0 + lane) * 8;
        const float li = GT[h], lfg = GT[4 + h];
        float b = lfg;
#pragma unroll
        for (int o = 1; o < 64; o <<= 1) { const float x = __shfl_up(b, o); if (lane >= o) b += x; }
        const float a = li - b; float pm = a;
#pragma unroll
        for (int o = 1; o < 64; o <<= 1) { const float x = __shfl_up(pm, o); if (lane >= o) pm = fmaxf(pm, x); }
        const float M = fmaxf(pm, mcar), wi = __expf(mcar - M);
        const float M63 = __shfl(M, 63);
        const float wg = __expf(a - M63), dec = __expf(mcar - M63);
        if (FULL && w == 0) { SCA[lane] = a; SCM[lane] = M; SCWI[lane] = wi; SCE[lane] = __expf(-(b + M)); }
        if (tg == 0) DEC[k] = dec;
        float wq[4], wk[4], bq, bk;
        { const float* cw = P.in[11] + layer * 4096; const float* cb = P.in[12] + layer * 1024;
#pragma unroll
          for (int j = 0; j < 4; ++j) { wq[j] = cw[j * 1024 + h * 128 + k]; wk[j] = cw[j * 1024 + 512 + h * 128 + k]; }
          bq = cb[h * 128 + k]; bk = cb[512 + h * 128 + k]; }
        const bf16_t* CQp = (const bf16_t*)(ws + WS_CQ) + h * 128 + k; const bf16_t* CKp = (const bf16_t*)(ws + WS_CK) + h * 128 + k;
#pragma unroll
        for (int hf = 0; hf < 2; ++hf) {
            float rq[11], rkk[11];
#pragma unroll
            for (int i = 0; i < 11; ++i) { const int t = t0 + 16 * tg + 8 * hf - 3 + i; const bool ok = t >= 0; const size_t tt = ok ? (size_t)t : 0;
                const float kx = bf2f(CKp[tt * 512]); rkk[i] = ok ? kx : 0.f;
                if (FULL) { const float qx = bf2f(CQp[tt * 512]); rq[i] = ok ? qx : 0.f; } else rq[i] = 0.f; }
#pragma unroll
            for (int i = 0; i < 8; ++i) {
                const float kv = siluf_(bk + wk[0] * rkk[i] + wk[1] * rkk[i + 1] + wk[2] * rkk[i + 2] + wk[3] * rkk[i + 3]) * 0.08838834764831845f;
                const int t = 16 * tg + 8 * hf + i; const float wgt = __shfl(wg, t);
                if (FULL) { const float qv = siluf_(bq + wq[0] * rq[i] + wq[1] * rq[i + 1] + wq[2] * rq[i + 2] + wq[3] * rq[i + 3]); const float wit = __shfl(wi, t);
                    QT[t * 136 + k] = f2bf(qv); KT[t * 136 + k] = f2bf(kv); QH[t * 136 + k] = f2bf(qv * wit); }
                khv[8 * hf + i] = kv * wgt; }
        }
    }
    { unsigned char* kp = lds + CH_KHT + k * 144 + tg * 32; *(u32x4*)kp = pack8(khv); *(u32x4*)(kp + 16) = pack8(khv + 8); }
}

template <int MODE  >
DI void chain_unit(const Params& P, unsigned char* lds, int layer, int batch, int h, int seg, unsigned* flags  ) {
    const int tid = opaque((int)threadIdx.x), lane = tid & 63, w = __builtin_amdgcn_readfirstlane(tid >> 6), fr = lane & 15, fq = lane >> 4;
    const int k = tid & 127, tg = w >> 1;
    unsigned char* ws = P.ws;
    float* OB = (float*)(lds + CH_OB); float* DEC = (float*)(lds + CH_DEC);
    float* NV = (float*)(lds + CH_NV); float* SCA = (float*)(lds + CH_SC); float* SCM = SCA + 64; float* SCWI = SCA + 128; float* SCE = SCA + 192;
    float* MC = (float*)(lds + CH_MC); float* DT = (float*)(lds + CH_DT); float* NL = (float*)(lds + CH_NL);
    bf16_t* Y = (bf16_t*)(ws + WS_Y);
    float* SIN = (float*)(ws + WS_STATE) + (size_t)((MODE * 4 + h) * NSEG) * SIN_FLOATS;
    if (MODE == 1) {
        float* SB = OB; float* SP = OB + 256;
        if (tid < 256) { const float* GT = (const float*)(ws + WS_GATES) + (size_t)(tid * 64) * 8; float b = 0.f, pm = -1e30f;
#pragma unroll 8
            for (int s = 0; s < 64; ++s) { b += GT[s * 8 + 4 + h]; pm = fmaxf(pm, GT[s * 8 + h] - b); }
            SB[tid] = b; SP[tid] = pm; }
        __syncthreads();
        if (tid == 0) { float m = 0.f;
#pragma unroll 1
            for (int c = 0; c < 256; ++c) { MC[c] = m; m = SB[c] + fmaxf(SP[c], m); } }
        __syncthreads();
    }
    f32x4 Sacc[8];
#pragma unroll
    for (int i = 0; i < 8; ++i) Sacc[i] = (f32x4){0.f, 0.f, 0.f, 0.f};
    float dtot = 1.f, nloc = 0.f;
    if (seg < NSEG - 1) {
#pragma unroll 1
        for (int cc = 0; cc < CPS; ++cc) {
            const int chunk = seg * CPS + cc, t0 = chunk * 64;
            const float mcar = (MODE == 1) ? MC[chunk] : 0.f;
            chain_prep<MODE, false>(P, lds, layer, h, t0, tid, lane, w, k, tg, mcar);
            __syncthreads();
            if (tid < 128) { const float d = DEC[tid]; dtot *= d;
                if (MODE == 1) { float sum = 0.f;
#pragma unroll
                    for (int c8 = 0; c8 < 8; ++c8) { float f[8]; unpack8(*(const u32x4*)(lds + CH_KHT + tid * 144 + c8 * 16), f);
#pragma unroll
                        for (int i = 0; i < 8; ++i) sum += f[i]; }
                    nloc = d * nloc + sum; } }
            bf16x8 vf[2];
#pragma unroll
            for (int ks = 0; ks < 2; ++ks) vf[ks] = *(const bf16x8*)(lds + CH_VT + (16 * w + fr) * 144 + (32 * ks + 8 * fq) * 2);
#pragma unroll
            for (int mb = 0; mb < 8; ++mb) { const f32x4 d = *(const f32x4*)(DEC + 16 * mb + 4 * fq); Sacc[mb] = Sacc[mb] * d;
#pragma unroll
                for (int ks = 0; ks < 2; ++ks) { const bf16x8 af = *(const bf16x8*)(lds + CH_KHT + (16 * mb + fr) * 144 + (32 * ks + 8 * fq) * 2); Sacc[mb] = mfma16(af, vf[ks], Sacc[mb]); } }
            __syncthreads();
        }
    }
    if (tid < 128) { DT[tid] = dtot; NL[tid] = nloc; }
    if (seg > 0) {
        if (tid == 0) { while (__hip_atomic_load(flags + seg, __ATOMIC_RELAXED, __HIP_MEMORY_SCOPE_AGENT) == 0u) __builtin_amdgcn_s_sleep(4); }
        __syncthreads();
        __threadfence();
    } else __syncthreads();
    {
        float* sin_me = SIN + (size_t)seg * SIN_FLOATS; float* sin_nx = SIN + (size_t)(seg + 1) * SIN_FLOATS;
        float n_in = 0.f;
        if (seg > 0 && tid < 128) n_in = __hip_atomic_load(sin_me + 16384 + tid, __ATOMIC_RELAXED, __HIP_MEMORY_SCOPE_AGENT);
#pragma unroll
        for (int mb = 0; mb < 8; ++mb) {
            f32x4 sin = (f32x4){0.f, 0.f, 0.f, 0.f};
            if (seg > 0) sin = *(const f32x4*)(sin_me + ((w * 8 + mb) * 64 + lane) * 4);
            if (seg < NSEG - 1) { const f32x4 d = *(const f32x4*)(DT + 16 * mb + 4 * fq); *(f32x4*)(sin_nx + ((w * 8 + mb) * 64 + lane) * 4) = d * sin + Sacc[mb]; }
            Sacc[mb] = sin;
        }
        if (tid < 128) { if (seg < NSEG - 1) sin_nx[16384 + tid] = dtot * n_in + nloc; if (MODE == 1) NV[tid] = n_in; }
        if (seg < NSEG - 1) {
            __threadfence();
            __syncthreads();
            if (tid == 0) __hip_atomic_store(flags + seg + 1, 1u, __ATOMIC_RELEASE, __HIP_MEMORY_SCOPE_AGENT);
        }
    }
    __syncthreads();
#pragma unroll 1
    for (int cc = 0; cc < CPS; ++cc) {
        const int chunk = seg * CPS + cc, t0 = chunk * 64;
        const float mcar = (MODE == 1) ? MC[chunk] : 0.f;
        chain_prep<MODE, true>(P, lds, layer, h, t0, tid, lane, w, k, tg, mcar);
        __syncthreads();
        {
            const int mb = w >> 1;
#pragma unroll
            for (int nn = 0; nn < 2; ++nn) { const int nb = (w & 1) * 2 + nn; f32x4 acc = (f32x4){0.f, 0.f, 0.f, 0.f};
                if (nb <= mb) {
#pragma unroll
                    for (int ks = 0; ks < 4; ++ks) { const bf16x8 af = *(const bf16x8*)(lds + CH_QT + (16 * mb + fr) * 272 + (32 * ks + 8 * fq) * 2);
                        const bf16x8 bfv = *(const bf16x8*)(lds + CH_KT + (16 * nb + fr) * 272 + (32 * ks + 8 * fq) * 2); acc = mfma16(af, bfv, acc); }
                }
                const int s = 16 * nb + fr; float as = 0.f; if (MODE == 1) as = SCA[s];
#pragma unroll
                for (int r = 0; r < 4; ++r) { const int t = 16 * mb + 4 * fq + r; float v = 0.f;
                    if (s <= t) { v = acc[r]; if (MODE == 1) v *= __expf(as - SCM[t]); }
                    ((bf16_t*)(lds + CH_AM))[t * 72 + s] = f2bf(v); }
            }
        }
        if (MODE == 1 && tid < 128) { float sum = 0.f;
#pragma unroll
            for (int c8 = 0; c8 < 8; ++c8) { float f[8]; unpack8(*(const u32x4*)(lds + CH_KHT + tid * 144 + c8 * 16), f);
#pragma unroll
                for (int i = 0; i < 8; ++i) sum += f[i]; }
            NV[((cc + 1) & 1) * 128 + tid] = DEC[tid] * NV[(cc & 1) * 128 + tid] + sum; }
        __syncthreads();
        {
            bf16x8 vf[2];
#pragma unroll
            for (int ks = 0; ks < 2; ++ks) vf[ks] = *(const bf16x8*)(lds + CH_VT + (16 * w + fr) * 144 + (32 * ks + 8 * fq) * 2);
            bf16x8 sb[4];
#pragma unroll
            for (int ks = 0; ks < 4; ++ks) { u32x4 pp; pp.x = pk2(Sacc[2 * ks][0], Sacc[2 * ks][1]); pp.y = pk2(Sacc[2 * ks][2], Sacc[2 * ks][3]);
                pp.z = pk2(Sacc[2 * ks + 1][0], Sacc[2 * ks + 1][1]); pp.w = pk2(Sacc[2 * ks + 1][2], Sacc[2 * ks + 1][3]); sb[ks] = __builtin_bit_cast(bf16x8, pp); }
#pragma unroll
            for (int mb = 0; mb < 4; ++mb) { f32x4 o = (f32x4){0.f, 0.f, 0.f, 0.f};
#pragma unroll
                for (int ks = 0; ks < 2; ++ks) { const bf16x8 af = *(const bf16x8*)(lds + CH_AM + (16 * mb + fr) * 144 + (32 * ks + 8 * fq) * 2); o = mfma16(af, vf[ks], o); }
#pragma unroll
                for (int ks = 0; ks < 4; ++ks) { const unsigned char* qp = lds + CH_QH + (16 * mb + fr) * 272 + (32 * ks + 4 * fq) * 2;
                    const s16x4 lo = *(const s16x4*)qp, hi = *(const s16x4*)(qp + 32); const bf16x8 af = __builtin_shufflevector(lo, hi, 0, 1, 2, 3, 4, 5, 6, 7); o = mfma16(af, sb[ks], o); }
#pragma unroll
                for (int r = 0; r < 4; ++r) OB[(16 * mb + 4 * fq + r) * 132 + 16 * w + fr] = o[r];
            }
#pragma unroll
            for (int mb = 0; mb < 8; ++mb) { const f32x4 d = *(const f32x4*)(DEC + 16 * mb + 4 * fq); Sacc[mb] = Sacc[mb] * d;
#pragma unroll
                for (int ks = 0; ks < 2; ++ks) { const bf16x8 af = *(const bf16x8*)(lds + CH_KHT + (16 * mb + fr) * 144 + (32 * ks + 8 * fq) * 2); Sacc[mb] = mfma16(af, vf[ks], Sacc[mb]); } }
        }
        __syncthreads();
        {
            const int t = tid >> 3, dc = tid & 7; float o[16];
#pragma unroll
            for (int i = 0; i < 4; ++i) { const f32x4 x = *(const f32x4*)(OB + t * 132 + 16 * dc + 4 * i); o[4 * i] = x.x; o[4 * i + 1] = x.y; o[4 * i + 2] = x.z; o[4 * i + 3] = x.w; }
            const size_t row = (size_t)(t0 + t);
            if (MODE == 1) {
                float f[8]; unpack8(*(const u32x4*)(lds + CH_AM + t * 144 + dc * 16), f);
                float rsum = 0.f;
#pragma unroll
                for (int i = 0; i < 8; ++i) rsum += f[i];
                float qn = 0.f; const float* nv = NV + (cc & 1) * 128 + 16 * dc;
                float qf8[8]; unpack8(*(const u32x4*)(lds + CH_QT + t * 272 + dc * 32), qf8);
#pragma unroll
                for (int i = 0; i < 8; ++i) qn += qf8[i] * nv[i];
                unpack8(*(const u32x4*)(lds + CH_QT + t * 272 + dc * 32 + 16), qf8);
#pragma unroll
                for (int i = 0; i < 8; ++i) qn += qf8[i] * nv[8 + i];
                rsum += __shfl_xor(rsum, 1); rsum += __shfl_xor(rsum, 2); rsum += __shfl_xor(rsum, 4);
                qn += __shfl_xor(qn, 1); qn += __shfl_xor(qn, 2); qn += __shfl_xor(qn, 4);
                const float nq = rsum + SCWI[t] * qn; const float den = 1.f / fmaxf(fabsf(nq), SCE[t]);
                const bf16_t* ogp = (const bf16_t*)(ws + WS_OG) + row * 512 + h * 128 + 16 * dc; float og[16];
                unpack8(*(const u32x4*)ogp, og); unpack8(*(const u32x4*)(ogp + 8), og + 8);
#pragma unroll
                for (int i = 0; i < 16; ++i) o[i] = o[i] * den * og[i];
            }
            float ss = 0.f;
#pragma unroll
            for (int i = 0; i < 16; ++i) ss += o[i] * o[i];
            ss += __shfl_xor(ss, 1); ss += __shfl_xor(ss, 2); ss += __shfl_xor(ss, 4);
            const float rn = rsqrtf(ss * (1.f / 128.f) + EPS);
            const float* g = (MODE == 0 ? P.in[7] : P.in[13]) + layer * 128 + 16 * dc;
            bf16_t* yp = Y + row * DMIX + (MODE == 0 ? 0 : 1024) + h * 128 + 16 * dc; float gt[16];
            unpack8(*(const u32x4*)yp, gt); unpack8(*(const u32x4*)(yp + 8), gt + 8);
#pragma unroll
            for (int i = 0; i < 16; ++i) o[i] = o[i] * rn * g[i] * gt[i];
            *(u32x4*)yp = pack8(o); *(u32x4*)(yp + 8) = pack8(o + 8);
        }
        __syncthreads();
    }
}

#ifdef DIS_C0
#define ENA_C0(x)
#else
#define ENA_C0(x) x
#endif
#ifdef DIS_C1
#define ENA_C1(x)
#else
#define ENA_C1(x) x
#endif
#ifdef DIS_A2
#define ENA_A2(x)
#else
#define ENA_A2(x) x
#endif
#ifdef DIS_A1
#define ENA_A1(x)
#else
#define ENA_A1(x) x
#endif
#ifndef PROBE_SEL
#define PROBE_SEL 0
#endif
#if PROBE_SEL
#define STAMP(i) do { const unsigned long long n_ = wall_clock64(); tacc##i += n_ - tprev; tprev = n_; } while (0)
#else
#define STAMP(i) do {} while (0)
#endif
__global__ void __launch_bounds__(NTHR, 2) hymba_fwd(Params P) {
    extern __shared__ __attribute__((aligned(16))) unsigned char lds[];
    cg::grid_group grid = cg::this_grid();
    const int tid = opaque((int)threadIdx.x), bid = blockIdx.x, G = gridDim.x;
    unsigned char* ws = P.ws;
    unsigned* CTL = (unsigned*)(ws + WS_CTL);
    volatile int* s_unit = (volatile int*)(lds + LDS_UNIT_OFF);

#if PROBE_SEL
    unsigned long long tprev = wall_clock64(); const unsigned long long tstart = tprev; unsigned long long tacc0 = 0, tacc1 = 0, tacc2 = 0, tacc3 = 0, tacc4 = 0;
#endif
    phase0(P, lds);
    for (int b = 0; b < NBATCH; ++b) {
        for (int l = 0; l < 2; ++l) {
            const float* xold = (l == 0 ? P.in[0] : (const float*)P.out) + (size_t)b * MP * DM;
            prep_rows(P, xold, l);
            grid.sync(); STAMP(0);
            {
                const int nt_in = (MP / 256) * (NIN / 128);
                const int nt_kv = (b == 0 && l == 0) ? 2 * 2 * 8 : 0;
                for (int tile = bid; tile < nt_in + nt_kv; tile += G) {
                    if (tile < nt_in) { const int tm = tile / (NIN / 128), tn = tile % (NIN / 128);
                        gemm_tile((const bf16_t*)(ws + WS_XB), DM, (const bf16_t*)(ws + WS_WIN) + (size_t)l * NIN * DM, DM, DM, tm * 256, tn * 128, lds,
                                  [&](const float* T, int r0, int c0) { epi_inproj(P, T, r0, c0, l, b); });
                    } else { int r = tile - nt_in; const int ll = r / 16; r -= ll * 16; const int tm = r / 8, tn = r % 8;
                        gemm_tile((const bf16_t*)(ws + WS_MNB), DM, (const bf16_t*)(ws + WS_WKV) + (size_t)ll * DM * DM, DM, DM, tm * 256, tn * 128, lds,
                                  [&](const float* T, int r0, int c0) { epi_kvmem(P, T, r0, c0, ll); });
                    }
                }
            }
            grid.sync(); STAMP(1);
            {
                unsigned* ctr = CTL + 16 * (b * 2 + l);
#if PROBE_SEL
                const unsigned long long tq0 = wall_clock64();
#endif
                if (bid < 128) {
                    const int md = bid >> 6, hh = (bid >> 4) & 3, sg = bid & 15;
                    unsigned* fl = CTL + 128 + ((b * 2 + l) * 2 + md) * 64 + hh * 16;
                    if (md == 0) { ENA_C0(chain_unit<0>(P, lds, l, b, hh, sg, fl)); }
                    else { ENA_C1(chain_unit<1>(P, lds, l, b, hh, sg, fl)); }
#if PROBE_SEL
                    if (bid == ((PROBE_SEL == 6) ? 127 : 63)) tacc4 += wall_clock64() - tq0;
#endif
                }
                for (;;) {
                    if (tid == 0) *s_unit = (int)atomicAdd(ctr, 1u);
                    __syncthreads();
                    const int u = __builtin_amdgcn_readfirstlane(*s_unit);
                    __syncthreads();
                    if (u >= 512 + 256) break;
                    if (u < 512) { ENA_A2(attn_unit<2>(P, lds, l, b, u & 3, 127 - (u >> 2))); }
                    else { const int i = u - 512; ENA_A1(attn_unit<1>(P, lds, l, b, i & 3, i >> 2)); }
                }
#if PROBE_SEL
                if (bid == 200) tacc4 += wall_clock64() - tq0;
#endif
            }
            grid.sync(); STAMP(2);
            {
                const int nt = (MP / 256) * (DM / 128);
                float* outp = P.out + (size_t)b * MP * DM;
                for (int tile = bid; tile < nt; tile += G) { const int tm = tile / 8, tn = tile % 8;
                    gemm_tile((const bf16_t*)(ws + WS_Y), DMIX, (const bf16_t*)(ws + WS_WOUT) + (size_t)l * DM * DMIX, DMIX, DMIX, tm * 256, tn * 128, lds,
                              [&](const float* T, int r0, int c0) { epi_outproj(T, xold, outp, r0, c0); });
                }
            }
            grid.sync(); STAMP(3);
        }
    }
#if PROBE_SEL
    if (bid == ((PROBE_SEL == 7) ? 200 : (PROBE_SEL == 6) ? 127 : (PROBE_SEL == 5) ? 63 : 0) && tid == 0) {
        unsigned long long sel = (PROBE_SEL == 1) ? tacc0 : (PROBE_SEL == 2) ? tacc1 : (PROBE_SEL == 3) ? tacc2 : (PROBE_SEL == 4) ? tacc3 : tacc4;
        if (sel > 10000000ull) sel = 10000000ull;
        const unsigned long long target = 5000000ull + sel;
        while (wall_clock64() - tstart < target) __builtin_amdgcn_s_sleep(32);
    }
#endif
}

extern "C" void kernel_launch(void* const* d_in, const int* in_sizes, int n_in, void* d_out, int out_size, void* d_ws, size_t ws_size, hipStream_t stream) {
    static int grid = 0;
    if (grid == 0) {
        if (n_in != 18 || ws_size < WS_END) { fprintf(stderr, "kernel_launch: unexpected n_in %d or ws_size %zu < %zu\n", n_in, ws_size, (size_t)WS_END); grid = -1; return; }
        int dev = 0, cus = 0, per_cu = 0;
        hipGetDevice(&dev);
        hipDeviceGetAttribute(&cus, hipDeviceAttributeMultiprocessorCount, dev);
        hipFuncSetAttribute((const void*)hymba_fwd, hipFuncAttributeMaxDynamicSharedMemorySize, LDS_BYTES);
        hipOccupancyMaxActiveBlocksPerMultiprocessor(&per_cu, (const void*)hymba_fwd, NTHR, LDS_BYTES);
        if (per_cu < 1) per_cu = 1;
        grid = cus * per_cu;
    }
    if (grid < 0) return;
    Params p{};
    for (int i = 0; i < 18; ++i) p.in[i] = (const float*)d_in[i];
    p.out = (float*)d_out; p.ws = (unsigned char*)d_ws;
    for (int j = 0; j < 8; ++j) p.inv_freq[j] = (float)pow(500000.0, -(double)(2 * j) / 16.0);
    p.mode = 0; p.pad = 0;
    void* args[] = {&p};
    hipError_t e = hipLaunchCooperativeKernel((const void*)hymba_fwd, dim3(grid), dim3(NTHR), args, LDS_BYTES, stream);
    if (e != hipSuccess) fprintf(stderr, "cooperative launch failed: %s (grid %d)\n", hipGetErrorString(e), grid);
}
```

```cpp
#include <hip/hip_runtime.h>
#include <hip/hip_cooperative_groups.h>
#include <cstdio>
#include <cstdint>
#include <cmath>
namespace cg = cooperative_groups;

#define DI __device__ __forceinline__
typedef unsigned short bf16_t;
typedef short bf16x8 __attribute__((ext_vector_type(8)));
typedef short s16x4 __attribute__((ext_vector_type(4)));
typedef float f32x2 __attribute__((ext_vector_type(2)));
typedef float f32x4 __attribute__((ext_vector_type(4)));
typedef float f32x16 __attribute__((ext_vector_type(16)));
typedef __bf16 bf16x2v __attribute__((ext_vector_type(2)));
typedef unsigned u32x2 __attribute__((ext_vector_type(2)));
typedef unsigned u32x4 __attribute__((ext_vector_type(4)));

constexpr int SEQ = 16384, DM = 1024, NBATCH = 2, MP = 16384;
constexpr int NIN = 7680, NINO = 7688, DMIX = 2048;
constexpr int NTHR = 512;
constexpr float EPS = 1e-6f;
constexpr int LDS_BYTES = 143360;
constexpr int LDS_UNIT_OFF = 143344;

constexpr size_t WS_CTL   = 0;
constexpr size_t WS_WIN   = 4096;
constexpr size_t WS_WOUT  = WS_WIN  + (size_t)2 * NIN * DM * 2;
constexpr size_t WS_WKV   = WS_WOUT + (size_t)2 * DM * DMIX * 2;
constexpr size_t WS_MNB   = WS_WKV  + (size_t)2 * DM * DM * 2;
constexpr size_t WS_KMB   = WS_MNB  + (size_t)512 * DM * 2;
constexpr size_t WS_VMT   = WS_KMB  + (size_t)2 * 512 * 512 * 2;
constexpr size_t WS_COS   = WS_VMT  + (size_t)2 * 2 * 512 * 256 * 2;
constexpr size_t WS_SIN   = WS_COS  + (size_t)32768 * 8 * 4;
constexpr size_t WS_LB    = WS_SIN  + (size_t)32768 * 8 * 4;
constexpr size_t WS_XB    = WS_LB   + 4096;
constexpr size_t WS_RSTD  = WS_XB   + (size_t)MP * DM * 2;
constexpr size_t WS_GATES = WS_RSTD + (size_t)MP * 4;
constexpr size_t SZ512    = (size_t)MP * 512 * 2;
constexpr size_t WS_QA    = WS_GATES + (size_t)MP * 8 * 4;
constexpr size_t WS_LF    = WS_QA + SZ512;
constexpr size_t WS_VAT   = WS_LF + SZ512;
constexpr size_t WS_QB    = WS_VAT + SZ512;
constexpr size_t WS_KB    = WS_QB + SZ512;
constexpr size_t WS_VBT   = WS_KB + SZ512;
constexpr size_t WS_CQ    = WS_VBT + SZ512;
constexpr size_t WS_CK    = WS_CQ + SZ512;
constexpr size_t WS_CVT   = WS_CK + SZ512;
constexpr size_t WS_OG    = WS_CVT + SZ512;
constexpr size_t WS_QX    = WS_OG + SZ512;
constexpr size_t WS_Y     = WS_QX + SZ512;
constexpr size_t WS_STATE = WS_Y + (size_t)MP * DMIX * 2;
constexpr size_t WS_END   = WS_STATE + (size_t)2 * 4 * 16 * (16384 + 128) * 4;

struct Params {
    const float* in[18];
    float* out;
    unsigned char* ws;
    float inv_freq[8];
    int mode;
    int pad;
};

DI float bf2f(bf16_t v) { return __uint_as_float(((unsigned)v) << 16); }
DI unsigned pk2(float lo, float hi) { f32x2 v = {lo, hi}; bf16x2v b = __builtin_convertvector(v, bf16x2v); return __builtin_bit_cast(unsigned, b); }
DI bf16_t f2bf(float x) { return (bf16_t)(pk2(x, 0.f) & 0xffffu); }
DI float wave_sum(float v) {
#pragma unroll
    for (int o = 1; o < 64; o <<= 1) v += __shfl_xor(v, o);
    return v;
}
DI float sigmoidf_(float x) { return 1.f / (1.f + __expf(-x)); }
DI float siluf_(float x) { return x / (1.f + __expf(-x)); }
DI f32x4 mfma16(bf16x8 a, bf16x8 b, f32x4 c) { return __builtin_amdgcn_mfma_f32_16x16x32_bf16(a, b, c, 0, 0, 0); }
DI f32x16 mfma32(bf16x8 a, bf16x8 b, f32x16 c) { return __builtin_amdgcn_mfma_f32_32x32x16_bf16(a, b, c, 0, 0, 0); }
DI int opaque(int x) { asm volatile("" : "+v"(x)); return x; }
DI int crow(int r, int h2) { return (r & 3) + 8 * (r >> 2) + 4 * h2; }
DI void unpack8(u32x4 u, float* f) {
    f[0] = __uint_as_float(u.x << 16); f[1] = __uint_as_float(u.x & 0xffff0000u);
    f[2] = __uint_as_float(u.y << 16); f[3] = __uint_as_float(u.y & 0xffff0000u);
    f[4] = __uint_as_float(u.z << 16); f[5] = __uint_as_float(u.z & 0xffff0000u);
    f[6] = __uint_as_float(u.w << 16); f[7] = __uint_as_float(u.w & 0xffff0000u);
}
DI u32x4 pack8(const float* f) { u32x4 o; o.x = pk2(f[0], f[1]); o.y = pk2(f[2], f[3]); o.z = pk2(f[4], f[5]); o.w = pk2(f[6], f[7]); return o; }

DI void transpose_tile(const float* src, int ldsrc, int srccol0, const float* g, bf16_t* dst, int lddst, int k0, int n0, float* T, int tid) {
    const int n = tid & 63, kk = tid >> 6;
#pragma unroll
    for (int i = 0; i < 8; ++i) { const int k = kk + 8 * i; float v = src[(size_t)(k0 + k) * ldsrc + srccol0 + n]; if (g) v *= g[k0 + k]; T[k * 65 + n] = v; }
    __syncthreads();
    const int nn = tid >> 3, kc = tid & 7;
    float f[8];
#pragma unroll
    for (int i = 0; i < 8; ++i) f[i] = T[(8 * kc + i) * 65 + nn];
    *(u32x4*)(dst + (size_t)(n0 + nn) * lddst + k0 + 8 * kc) = pack8(f);
    __syncthreads();
}

DI void phase0(const Params& P, unsigned char* lds) {
    const int tid = opaque((int)threadIdx.x), bid = blockIdx.x, G = gridDim.x;
    unsigned char* ws = P.ws;
    float* T = (float*)lds;
    if (bid == 0) { for (int i = tid; i < 1024; i += NTHR) ((unsigned*)(ws + WS_CTL))[i] = 0u; }
    constexpr int T_IN = 16 * 120, T_OUT = 32 * 16, T_KV = 16 * 16;
    constexpr int NT = 2 * (T_IN + T_OUT + T_KV);
    for (int it = bid; it < NT; it += G) {
        int r = it; const int l = r / (T_IN + T_OUT + T_KV); r -= l * (T_IN + T_OUT + T_KV);
        if (r < T_IN) { const int kb = r / 120, nb = r % 120, n0 = nb * 64; const int sc = n0 < 6144 ? n0 : n0 + 8;
            transpose_tile(P.in[4] + (size_t)l * DM * NINO, NINO, sc, P.in[3] + l * DM, (bf16_t*)(ws + WS_WIN) + (size_t)l * NIN * DM, DM, kb * 64, n0, T, tid); continue; }
        r -= T_IN;
        if (r < T_OUT) { const int kb = r / 16, nb = r % 16;
            transpose_tile(P.in[17] + (size_t)l * DMIX * DM, DM, nb * 64, nullptr, (bf16_t*)(ws + WS_WOUT) + (size_t)l * DM * DMIX, DMIX, kb * 64, nb * 64, T, tid); continue; }
        r -= T_OUT;
        { const int kb = r / 16, nb = r % 16;
            transpose_tile(P.in[15] + (size_t)l * DM * DM, DM, nb * 64, P.in[14] + l * DM, (bf16_t*)(ws + WS_WKV) + (size_t)l * DM * DM, DM, kb * 64, nb * 64, T, tid); }
    }
    const int gt = bid * NTHR + tid, NG = G * NTHR;
    {
        const int* pos = (const int*)P.in[2];
        float* C = (float*)(ws + WS_COS); float* Sn = (float*)(ws + WS_SIN);
        for (int i = gt; i < 32768 * 8; i += NG) { const int row = i >> 3, j = i & 7; const float ang = (float)pos[row] * P.inv_freq[j]; C[i] = cosf(ang); Sn[i] = sinf(ang); }
    }
    { float* LB = (float*)(ws + WS_LB); const float* lg = P.in[6];
      for (int i = gt; i < 512; i += NG) { LB[i] = 0.f; LB[512 + i] = 1.f / (1.f + expf(lg[i] - lg[512 + i])); } }
    { const int lane = tid & 63, gw = (bid * NTHR + tid) >> 6, NGW = (G * NTHR) >> 6;
      for (int r = gw; r < 512; r += NGW) {
          const f32x4* xr = (const f32x4*)(P.in[1] + (size_t)r * DM) + lane; f32x4 v[4]; float s = 0.f;
#pragma unroll
          for (int j = 0; j < 4; ++j) { v[j] = xr[64 * j]; s += v[j].x * v[j].x + v[j].y * v[j].y + v[j].z * v[j].z + v[j].w * v[j].w; }
          const float rs = rsqrtf(wave_sum(s) * (1.f / DM) + EPS);
          u32x2* o = (u32x2*)((bf16_t*)(ws + WS_MNB) + (size_t)r * DM) + lane;
#pragma unroll
          for (int j = 0; j < 4; ++j) { u32x2 w; w.x = pk2(v[j].x * rs, v[j].y * rs); w.y = pk2(v[j].z * rs, v[j].w * rs); o[64 * j] = w; }
      } }
}

DI void prep_rows(const Params& P, const float* xsrc, int layer) {
    const int tid = opaque((int)threadIdx.x), lane = tid & 63, gw = (blockIdx.x * NTHR + tid) >> 6, NGW = (gridDim.x * NTHR) >> 6;
    unsigned char* ws = P.ws;
    const float* win = P.in[4] + (size_t)layer * DM * NINO; const float* ng = P.in[3] + layer * DM; const float* gb = P.in[5] + layer * 8;
    bf16_t* XB = (bf16_t*)(ws + WS_XB); float* RSTD = (float*)(ws + WS_RSTD); float* GATES = (float*)(ws + WS_GATES);
    for (int r = gw; r < MP; r += NGW) {
        const f32x4* xr = (const f32x4*)(xsrc + (size_t)r * DM) + lane; f32x4 v[4]; float s = 0.f;
#pragma unroll
        for (int j = 0; j < 4; ++j) { v[j] = xr[64 * j]; s += v[j].x * v[j].x + v[j].y * v[j].y + v[j].z * v[j].z + v[j].w * v[j].w; }
        const float rs = rsqrtf(wave_sum(s) * (1.f / DM) + EPS);
        u32x2* o = (u32x2*)(XB + (size_t)r * DM) + lane;
#pragma unroll
        for (int j = 0; j < 4; ++j) { u32x2 w; w.x = pk2(v[j].x, v[j].y); w.y = pk2(v[j].z, v[j].w); o[64 * j] = w; }
        float d[8];
#pragma unroll
        for (int g = 0; g < 8; ++g) d[g] = 0.f;
#pragma unroll
        for (int j = 0; j < 4; ++j) {
#pragma unroll
            for (int e = 0; e < 4; ++e) { const int k = 4 * lane + 256 * j + e; const float xv = v[j][e] * ng[k];
                const f32x4 w0 = *(const f32x4*)(win + (size_t)k * NINO + 6144); const f32x4 w1 = *(const f32x4*)(win + (size_t)k * NINO + 6148);
                d[0] += xv * w0.x; d[1] += xv * w0.y; d[2] += xv * w0.z; d[3] += xv * w0.w; d[4] += xv * w1.x; d[5] += xv * w1.y; d[6] += xv * w1.z; d[7] += xv * w1.w; }
        }
#pragma unroll
        for (int g = 0; g < 8; ++g) d[g] = wave_sum(d[g]) * rs;
        if (lane == 0) {
            RSTD[r] = rs;
            f32x4 gi, gf;
#pragma unroll
            for (int g = 0; g < 4; ++g) { gi[g] = d[g] + gb[g]; const float z = d[4 + g] + gb[4 + g]; gf[g] = fminf(z, 0.f) - log1pf(expf(-fabsf(z))); }
            *(f32x4*)(GATES + (size_t)r * 8) = gi; *(f32x4*)(GATES + (size_t)r * 8 + 4) = gf;
        }
    }
}

#if PROBE_SEL == 8
#define GEPI_ARG , unsigned long long& g_epi_ticks
#define GEPI_PASS , tacc4
#else
#define GEPI_ARG
#define GEPI_PASS
#endif
template <int VAR = 0, class Epi>
DI void gemm_tile(const bf16_t* A, int lda, const bf16_t* Bt, int ldb, int K, int row0, int col0, unsigned char* lds, const float* rowscale, const Epi& epi GEPI_ARG) {
    const int tid = opaque((int)threadIdx.x), lane = tid & 63, w = __builtin_amdgcn_readfirstlane(tid >> 6), wr = w >> 1, wc = w & 1, fr = lane & 15, fq = lane >> 4;
    constexpr int STG = 49152;
    f32x4 acc[4][4];
#pragma unroll
    for (int m = 0; m < 4; ++m)
#pragma unroll
        for (int n = 0; n < 4; ++n) acc[m][n] = (f32x4){0.f, 0.f, 0.f, 0.f};
    u32x4 ra0[4], rb0[2], ra1[4], rb1[2];
    float rsv = 1.f; if (rowscale && tid < 256) rsv = rowscale[row0 + tid];
    const int nt = K / 64;
    const int sc = tid & 7, sr0 = tid >> 3;
    const bf16_t* Ap = A + (size_t)(row0 + sr0) * lda + sc * 8;
    const bf16_t* Bp = Bt + (size_t)(col0 + sr0) * ldb + sc * 8;
    const int so = sr0 * 128 + ((sc ^ (sr0 & 7)) << 4);
#define G_LOAD(RA, RB, KT) do { _Pragma("unroll") for (int i = 0; i < 4; ++i) RA[i] = *(const u32x4*)(Ap + (size_t)(64 * i) * lda + (KT) * 64); \
        _Pragma("unroll") for (int i = 0; i < 2; ++i) RB[i] = *(const u32x4*)(Bp + (size_t)(64 * i) * ldb + (KT) * 64); } while (0)
#define G_STORE(RA, RB, BUF) do { unsigned char* NA_ = lds + (BUF) * STG; _Pragma("unroll") for (int i = 0; i < 4; ++i) *(u32x4*)(NA_ + so + i * 8192) = RA[i]; \
        _Pragma("unroll") for (int i = 0; i < 2; ++i) *(u32x4*)(NA_ + 32768 + so + i * 8192) = RB[i]; } while (0)
#define G_COMPUTE(BUF) do { const unsigned char* LA = lds + (BUF) * STG; const unsigned char* LB = LA + 32768; \
        _Pragma("unroll") for (int kk = 0; kk < 2; ++kk) { bf16x8 af[4], bfr[4]; const int ch = kk * 4 + fq; \
            _Pragma("unroll") for (int m = 0; m < 4; ++m) { const int r = wr * 64 + m * 16 + fr; af[m] = *(const bf16x8*)(LA + r * 128 + ((ch ^ (r & 7)) << 4)); } \
            _Pragma("unroll") for (int n = 0; n < 4; ++n) { const int r = wc * 64 + n * 16 + fr; bfr[n] = *(const bf16x8*)(LB + r * 128 + ((ch ^ (r & 7)) << 4)); } \
            _Pragma("unroll") for (int m = 0; m < 4; ++m) _Pragma("unroll") for (int n = 0; n < 4; ++n) acc[m][n] = mfma16(af[m], bfr[n], acc[m][n]); } } while (0)
    G_LOAD(ra0, rb0, 0);
    G_LOAD(ra1, rb1, 1);
    G_STORE(ra0, rb0, 0);
    __syncthreads();
    for (int t = 0; t < nt; t += 2) {
        if (VAR == 0 || VAR == 3) { G_LOAD(ra0, rb0, (t + 2 < nt ? t + 2 : nt - 1)); } __builtin_amdgcn_sched_barrier(0);
        G_COMPUTE(0);
        if (VAR != 2) { G_STORE(ra1, rb1, 1); }
        __syncthreads();
        if (VAR == 0 || VAR == 3) { G_LOAD(ra1, rb1, (t + 3 < nt ? t + 3 : nt - 1)); } __builtin_amdgcn_sched_barrier(0);
        G_COMPUTE(1);
        if (VAR != 2) { if (t + 2 < nt) G_STORE(ra0, rb0, 0); }
        __syncthreads();
    }
#undef G_LOAD
#undef G_STORE
#undef G_COMPUTE
    float* T = (float*)lds;
    if (VAR != 0) { f32x4 sm = (f32x4){0.f, 0.f, 0.f, 0.f};
#pragma unroll
        for (int m = 0; m < 4; ++m)
#pragma unroll
            for (int n = 0; n < 4; ++n) sm += acc[m][n];
        if (sm[0] + sm[1] + sm[2] + sm[3] == 12345.678f) T[tid] = sm[0];
        __syncthreads(); return; }
#pragma unroll
    for (int m = 0; m < 4; ++m)
#pragma unroll
        for (int n = 0; n < 4; ++n)
#pragma unroll
            for (int r = 0; r < 4; ++r) T[(wr * 64 + m * 16 + 4 * fq + r) * 132 + wc * 64 + n * 16 + fr] = acc[m][n][r];
    if (tid < 256) ((float*)(lds + 135168))[tid] = rsv;
    __syncthreads();
    epi(T, (const float*)(lds + 135168), row0, col0);
    __syncthreads();
}

DI void epi_inproj(const Params& P, const float* T, const float* RS, int row0, int col0, int layer, int batch) {
    const int tid = opaque((int)threadIdx.x); unsigned char* ws = P.ws;
    const int seg = col0 >> 9, cseg = col0 & 511;
    const bool transposed = (seg == 2 || seg == 6 || seg == 10);
    if (transposed) {
        bf16_t* dst = (bf16_t*)(ws + (seg == 2 ? WS_VAT : (seg == 6 ? WS_VBT : WS_CVT)));
#pragma unroll
        for (int j = 0; j < 8; ++j) { const int item = tid + NTHR * j, rc = item & 31, col = item >> 5; float f[8];
#pragma unroll
            for (int i = 0; i < 8; ++i) f[i] = T[(rc * 8 + i) * 132 + col] * RS[rc * 8 + i];
            *(u32x4*)(dst + (size_t)(cseg + col) * MP + row0 + rc * 8) = pack8(f); }
        return;
    }
    const float* LB = (const float*)(ws + WS_LB) + layer * 512;
    const float* COSt = (const float*)(ws + WS_COS); const float* SINt = (const float*)(ws + WS_SIN);
#pragma unroll
    for (int j = 0; j < 8; ++j) {
        const int item = tid + NTHR * j, r = item >> 4, ch = item & 15, row = row0 + r, c = cseg + ch * 8;
        const float rs = RS[r]; float v[8];
        { const f32x4 a = *(const f32x4*)(T + r * 132 + ch * 8), b = *(const f32x4*)(T + r * 132 + ch * 8 + 4);
          v[0] = a.x * rs; v[1] = a.y * rs; v[2] = a.z * rs; v[3] = a.w * rs; v[4] = b.x * rs; v[5] = b.y * rs; v[6] = b.z * rs; v[7] = b.w * rs; }
        bf16_t* dst = nullptr; size_t doff = (size_t)row * 512 + c;
        switch (seg) {
        case 0: { dst = (bf16_t*)(ws + WS_QA);
#pragma unroll
            for (int i = 0; i < 8; ++i) v[i] = siluf_(v[i]) * 0.08838834764831845f; } break;
        case 1: { dst = (bf16_t*)(ws + WS_LF);
#pragma unroll
            for (int i = 0; i < 8; ++i) { const float lb = LB[c + i]; v[i] = logf(fmaxf(lb + (1.f - lb) * sigmoidf_(v[i]), 1e-30f)); } } break;
        case 3: case 7: case 12: case 14: { dst = (bf16_t*)(ws + WS_Y); doff = (size_t)row * DMIX + (seg == 3 ? 0 : (seg == 7 ? 512 : (seg == 12 ? 1024 : 1536))) + c;
#pragma unroll
            for (int i = 0; i < 8; ++i) v[i] = siluf_(v[i]); } break;
        case 4: case 5: {
            dst = (bf16_t*)(ws + (seg == 4 ? WS_QB : WS_KB));
            float ss = 0.f;
#pragma unroll
            for (int i = 0; i < 8; ++i) ss += v[i] * v[i];
            ss += __shfl_xor(ss, 1); ss += __shfl_xor(ss, 2); ss += __shfl_xor(ss, 4);
            const float rn = rsqrtf(ss * (1.f / 64.f) + EPS);
            const float* g = P.in[8] + layer * 128 + (seg == 4 ? 0 : 64) + (ch & 7) * 8;
            const int grow = batch * SEQ + row; const int c7 = ch & 7;
            const float sc = (seg == 4) ? 0.125f : 1.f;
#pragma unroll
            for (int i = 0; i < 8; ++i) {
                float y = v[i] * rn * g[i];
                const float part = __shfl_xor(y, 1);
                const float cs = COSt[grow * 8 + i], sn = SINt[grow * 8 + i];
                if (c7 == 0) y = y * cs - part * sn; else if (c7 == 1) y = y * cs + part * sn;
                v[i] = y * sc;
            } } break;
        case 8: dst = (bf16_t*)(ws + WS_CQ); break;
        case 9: dst = (bf16_t*)(ws + WS_CK); break;
        case 11: { dst = (bf16_t*)(ws + WS_OG);
#pragma unroll
            for (int i = 0; i < 8; ++i) v[i] = sigmoidf_(v[i]); } break;
        case 13: { dst = (bf16_t*)(ws + WS_QX);
            float ss = 0.f;
#pragma unroll
            for (int i = 0; i < 8; ++i) ss += v[i] * v[i];
            ss += __shfl_xor(ss, 1); ss += __shfl_xor(ss, 2); ss += __shfl_xor(ss, 4); ss += __shfl_xor(ss, 8);
            const float rn = rsqrtf(ss * (1.f / 128.f) + EPS) * 0.08838834764831845f;
            const float* g = P.in[16] + layer * 256 + ch * 8;
#pragma unroll
            for (int i = 0; i < 8; ++i) v[i] = v[i] * rn * g[i]; } break;
        default: break;
        }
        *(u32x4*)(dst + doff) = pack8(v);
    }
}

DI void epi_kvmem(const Params& P, const float* T, const float* RS, int row0, int col0, int layer) {
    const int tid = opaque((int)threadIdx.x); unsigned char* ws = P.ws;
    if (col0 < 512) {
        bf16_t* dst = (bf16_t*)(ws + WS_KMB) + (size_t)layer * 512 * 512;
        const float* g = P.in[16] + layer * 256 + 128;
#pragma unroll
        for (int j = 0; j < 8; ++j) { const int item = tid + NTHR * j, r = item >> 4, ch = item & 15; float v[8];
            { const f32x4 a = *(const f32x4*)(T + r * 132 + ch * 8), b = *(const f32x4*)(T + r * 132 + ch * 8 + 4);
              v[0] = a.x; v[1] = a.y; v[2] = a.z; v[3] = a.w; v[4] = b.x; v[5] = b.y; v[6] = b.z; v[7] = b.w; }
            float ss = 0.f;
#pragma unroll
            for (int i = 0; i < 8; ++i) ss += v[i] * v[i];
            ss += __shfl_xor(ss, 1); ss += __shfl_xor(ss, 2); ss += __shfl_xor(ss, 4); ss += __shfl_xor(ss, 8);
            const float rn = rsqrtf(ss * (1.f / 128.f) + EPS);
#pragma unroll
            for (int i = 0; i < 8; ++i) v[i] = v[i] * rn * g[ch * 8 + i];
            *(u32x4*)(dst + (size_t)(row0 + r) * 512 + col0 + ch * 8) = pack8(v); }
    } else {
        const int b = row0 >> 8, m0 = row0 & 255;
        bf16_t* dst = (bf16_t*)(ws + WS_VMT) + (size_t)(layer * 2 + b) * 512 * 256;
#pragma unroll
        for (int j = 0; j < 8; ++j) { const int item = tid + NTHR * j, rc = item & 31, col = item >> 5; float f[8];
#pragma unroll
            for (int i = 0; i < 8; ++i) f[i] = T[(rc * 8 + i) * 132 + col];
            *(u32x4*)(dst + (size_t)(col0 - 512 + col) * 256 + m0 + rc * 8) = pack8(f); }
    }
}

DI void epi_outproj(const float* T, const float* xold, float* out, int grow0, int col0) {
    const int tid = opaque((int)threadIdx.x);
#pragma unroll
    for (int j = 0; j < 16; ++j) { const int item = tid + NTHR * j, r = item >> 5, c4 = item & 31;
        const size_t off = (size_t)(grow0 + r) * DM + col0 + c4 * 4;
        const f32x4 a = *(const f32x4*)(T + r * 132 + c4 * 4), x = *(const f32x4*)(xold + off);
        *(f32x4*)(out + off) = a + x; }
}

template <int NCOMP>
DI void attn_unit(const Params& P, unsigned char* lds, int layer, int batch, int h, int qb) {
    constexpr int NS = (NCOMP == 2) ? 4 : 8;
    constexpr int STG = 64 * 272 + 128 * 136;
    const int tid = opaque((int)threadIdx.x), lane = tid & 63, w = __builtin_amdgcn_readfirstlane(tid >> 6), l31 = lane & 31, h2 = lane >> 5;
    unsigned char* ws = P.ws;
    const int comp = (NCOMP == 2) ? (w >> 2) : 0;
    const int q0 = (NCOMP == 2) ? qb * 128 : qb * 256;
    const int qw = (NCOMP == 2) ? q0 + 32 * (w & 3) : q0 + 32 * w;
    const bf16_t* Qsrc = (const bf16_t*)(ws + (NCOMP == 2 ? WS_QB : WS_QX));
    const bf16_t* Ksrc; const bf16_t* Vsrc; int ldv, nkt;
    if (NCOMP == 2) { Ksrc = (const bf16_t*)(ws + WS_KB) + h * 128; Vsrc = (const bf16_t*)(ws + WS_VBT) + (size_t)(h * 128) * MP; ldv = MP; nkt = 2 * qb + 2; }
    else { Ksrc = (const bf16_t*)(ws + WS_KMB) + (size_t)layer * 512 * 512 + (size_t)batch * 256 * 512 + h * 128;
           Vsrc = (const bf16_t*)(ws + WS_VMT) + (size_t)(layer * 2 + batch) * 512 * 256 + (size_t)(h * 128) * 256; ldv = 256; nkt = 4; }
    bf16x8 qf[NS];
    { const bf16_t* qp = Qsrc + (size_t)(qw + l31) * 512 + h * 128 + comp * 64 + 8 * h2;
#pragma unroll
      for (int s = 0; s < NS; ++s) qf[s] = *(const bf16x8*)(qp + 16 * s);
      asm volatile("s_waitcnt vmcnt(0)" ::: "memory");
#pragma unroll
      for (int s = 0; s < NS; ++s) asm volatile("" : "+v"(qf[s])); }
    f32x16 O[4];
#pragma unroll
    for (int d = 0; d < 4; ++d)
#pragma unroll
        for (int i = 0; i < 16; ++i) O[d][i] = 0.f;
    float mrun = -1e30f, lsum = 0.f;
    u32x4 rk[2], rv[2]; int kr[2], kc[2], vr[2], vc[2];
#pragma unroll
    for (int i = 0; i < 2; ++i) { const int c = tid + NTHR * i; kr[i] = c >> 4; kc[i] = c & 15; vr[i] = c >> 3; vc[i] = c & 7; }
#pragma unroll
    for (int i = 0; i < 2; ++i) { rk[i] = *(const u32x4*)(Ksrc + (size_t)kr[i] * 512 + kc[i] * 8); rv[i] = *(const u32x4*)(Vsrc + (size_t)vr[i] * ldv + vc[i] * 8); }
#pragma unroll
    for (int i = 0; i < 2; ++i) { *(u32x4*)(lds + kr[i] * 272 + kc[i] * 16) = rk[i];
        unsigned char* vp = lds + 64 * 272 + vr[i] * 136 + vc[i] * 16; *(u32x2*)vp = (u32x2){rv[i].x, rv[i].y}; *(u32x2*)(vp + 8) = (u32x2){rv[i].z, rv[i].w}; }
    __syncthreads();
    for (int kt = 0; kt < nkt; ++kt) {
        const unsigned char* LK = lds + (kt & 1) * STG; const unsigned char* LV = LK + 64 * 272;
        if (kt + 1 < nkt) {
#pragma unroll
            for (int i = 0; i < 2; ++i) { rk[i] = *(const u32x4*)(Ksrc + (size_t)((kt + 1) * 64 + kr[i]) * 512 + kc[i] * 8); rv[i] = *(const u32x4*)(Vsrc + (size_t)vr[i] * ldv + (kt + 1) * 64 + vc[i] * 8); }
        }
        const bool active = (NCOMP == 1) || (kt * 64 <= qw + 31);
        if (active) {
            f32x16 S[2];
#pragma unroll
            for (int kb = 0; kb < 2; ++kb)
#pragma unroll
                for (int i = 0; i < 16; ++i) S[kb][i] = 0.f;
#pragma unroll
            for (int s = 0; s < NS; ++s)
#pragma unroll
                for (int kb = 0; kb < 2; ++kb) { const bf16x8 kf = *(const bf16x8*)(LK + (32 * kb + l31) * 272 + comp * 128 + (16 * s + 8 * h2) * 2); S[kb] = mfma32(kf, qf[s], S[kb]); }
            if (NCOMP == 2 && (kt * 64 + 63 > qw)) {
                const int qpos = qw + l31;
#pragma unroll
                for (int kb = 0; kb < 2; ++kb)
#pragma unroll
                    for (int i = 0; i < 16; ++i) { const int key = kt * 64 + 32 * kb + crow(i, h2); if (key > qpos) S[kb][i] = -1e30f; }
            }
            float mx = S[0][0];
#pragma unroll
            for (int kb = 0; kb < 2; ++kb)
#pragma unroll
                for (int i = 0; i < 16; ++i) mx = fmaxf(mx, S[kb][i]);
            mx = fmaxf(mx, __shfl_xor(mx, 32));
            const float mnew = fmaxf(mrun, mx), alpha = __expf(mrun - mnew);
            mrun = mnew;
            float ps = 0.f;
#pragma unroll
            for (int kb = 0; kb < 2; ++kb)
#pragma unroll
                for (int i = 0; i < 16; ++i) { const float p = __expf(S[kb][i] - mnew); S[kb][i] = p; ps += p; }
            lsum = lsum * alpha + ps;
            if (__any(alpha != 1.f)) {
#pragma unroll
                for (int d = 0; d < 4; ++d)
#pragma unroll
                    for (int i = 0; i < 16; ++i) O[d][i] *= alpha;
            }
#pragma unroll
            for (int kb = 0; kb < 2; ++kb)
#pragma unroll
                for (int s2 = 0; s2 < 2; ++s2) {
                    u32x4 pp; pp.x = pk2(S[kb][8 * s2 + 0], S[kb][8 * s2 + 1]); pp.y = pk2(S[kb][8 * s2 + 2], S[kb][8 * s2 + 3]); pp.z = pk2(S[kb][8 * s2 + 4], S[kb][8 * s2 + 5]); pp.w = pk2(S[kb][8 * s2 + 6], S[kb][8 * s2 + 7]);
                    const bf16x8 pf = __builtin_bit_cast(bf16x8, pp);
#pragma unroll
                    for (int d = 0; d < 4; ++d) {
                        const unsigned char* vp = LV + (32 * d + l31) * 136 + (32 * kb + 16 * s2 + 4 * h2) * 2;
                        const s16x4 lo = *(const s16x4*)vp, hi = *(const s16x4*)(vp + 16);
                        const bf16x8 vf = __builtin_shufflevector(lo, hi, 0, 1, 2, 3, 4, 5, 6, 7);
                        O[d] = mfma32(vf, pf, O[d]);
                    }
                }
        }
        if (kt + 1 < nkt) {
            unsigned char* NK = lds + ((kt + 1) & 1) * STG;
#pragma unroll
            for (int i = 0; i < 2; ++i) { *(u32x4*)(NK + kr[i] * 272 + kc[i] * 16) = rk[i];
                unsigned char* vp = NK + 64 * 272 + vr[i] * 136 + vc[i] * 16; *(u32x2*)vp = (u32x2){rv[i].x, rv[i].y}; *(u32x2*)(vp + 8) = (u32x2){rv[i].z, rv[i].w}; }
        }
        __syncthreads();
    }
    const float inv = 1.f / (lsum + __shfl_xor(lsum, 32));
#pragma unroll
    for (int d = 0; d < 4; ++d)
#pragma unroll
        for (int i = 0; i < 16; ++i) O[d][i] *= inv;
    bf16_t* Y = (bf16_t*)(ws + WS_Y);
    if (NCOMP == 1) {
        bf16_t* yp = Y + (size_t)(qw + l31) * DMIX + 1536 + h * 128;
#pragma unroll
        for (int d = 0; d < 4; ++d)
#pragma unroll
            for (int g = 0; g < 4; ++g) { const int dv = 32 * d + 8 * g + 4 * h2; const u32x2 gt = *(const u32x2*)(yp + dv);
                u32x2 o; o.x = pk2(O[d][4 * g + 0] * __uint_as_float(gt.x << 16), O[d][4 * g + 1] * __uint_as_float(gt.x & 0xffff0000u));
                o.y = pk2(O[d][4 * g + 2] * __uint_as_float(gt.y << 16), O[d][4 * g + 3] * __uint_as_float(gt.y & 0xffff0000u));
                *(u32x2*)(yp + dv) = o; }
        __syncthreads();
        return;
    }
    float* X = (float*)lds;
    const int ql = 32 * (w & 3) + l31;
    if (comp == 1) {
#pragma unroll
        for (int d = 0; d < 4; ++d)
#pragma unroll
            for (int i = 0; i < 16; ++i) X[ql * 132 + 32 * d + crow(i, h2)] = O[d][i];
    }
    __syncthreads();
    const float* lp = P.in[9] + layer * 256;
    float lam;
    { const float a = wave_sum(lp[lane] * lp[64 + lane]), b = wave_sum(lp[128 + lane] * lp[192 + lane]);
      const float lam_init = 0.8f - 0.6f * expf(-0.3f * (float)layer); lam = expf(a) - expf(b) + lam_init; }
    if (comp == 0) {
#pragma unroll
        for (int d = 0; d < 4; ++d)
#pragma unroll
            for (int i = 0; i < 16; ++i) { const int a = ql * 132 + 32 * d + crow(i, h2); X[a] = O[d][i] - lam * X[a]; }
    }
    __syncthreads();
    {
        const float lam_init = 0.8f - 0.6f * expf(-0.3f * (float)layer);
        const float* g = P.in[10] + layer * 128;
#pragma unroll
        for (int j = 0; j < 4; ++j) { const int item = tid + NTHR * j, r = item >> 4, ch = item & 15; float v[8];
            { const f32x4 a = *(const f32x4*)(X + r * 132 + ch * 8), b = *(const f32x4*)(X + r * 132 + ch * 8 + 4);
              v[0] = a.x; v[1] = a.y; v[2] = a.z; v[3] = a.w; v[4] = b.x; v[5] = b.y; v[6] = b.z; v[7] = b.w; }
            float ss = 0.f;
#pragma unroll
            for (int i = 0; i < 8; ++i) ss += v[i] * v[i];
            ss += __shfl_xor(ss, 1); ss += __shfl_xor(ss, 2); ss += __shfl_xor(ss, 4); ss += __shfl_xor(ss, 8);
            const float rn = rsqrtf(ss * (1.f / 128.f) + EPS) * (1.f - lam_init);
            bf16_t* yp = Y + (size_t)(q0 + r) * DMIX + 512 + h * 128 + ch * 8; float gt[8]; unpack8(*(const u32x4*)yp, gt);
#pragma unroll
            for (int i = 0; i < 8; ++i) v[i] = v[i] * rn * g[ch * 8 + i] * gt[i];
            *(u32x4*)yp = pack8(v); }
    }
    __syncthreads();
}

constexpr int NSEG = 16, CPS = 16;
constexpr int SIN_FLOATS = 16384 + 128;
constexpr int CH_QT = 0, CH_KT = 17408, CH_QH = 34816, CH_KHT = 52224, CH_VT = 70656, CH_AM = 89088, CH_OB = 98304, CH_PART = 132096,
              CH_DEC = 134144, CH_NV = 134656  , CH_SC = 135680  , CH_MC = 136704  ,
              CH_DT = 137728  , CH_NL = 138240  ;

template <int MODE, bool FULL>
DI void chain_prep(const Params& P, unsigned char* lds, int layer, int h, int t0, int tid, int lane, int w, int k, int tg, float mcar) {
    unsigned char* ws = P.ws;
    bf16_t* QT = (bf16_t*)(lds + CH_QT); bf16_t* KT = (bf16_t*)(lds + CH_KT); bf16_t* QH = (bf16_t*)(lds + CH_QH);
    float* PART = (float*)(lds + CH_PART); float* DEC = (float*)(lds + CH_DEC);
    float* SCA = (float*)(lds + CH_SC); float* SCM = SCA + 64; float* SCWI = SCA + 128; float* SCE = SCA + 192;
    const bf16_t* Vsrc = (const bf16_t*)(ws + (MODE == 0 ? WS_VAT : WS_CVT)) + (size_t)(h * 128) * MP;
#pragma unroll
    for (int i = 0; i < 2; ++i) { const int c = tid + NTHR * i, dv = c >> 3, ch = c & 7;
        *(u32x4*)(lds + CH_VT + dv * 144 + ch * 16) = *(const u32x4*)(Vsrc + (size_t)dv * MP + t0 + ch * 8); }
    float khv[16];
    if (MODE == 0) {
        const bf16_t* LFp = (const bf16_t*)(ws + WS_LF) + (size_t)(t0 + 16 * tg) * 512 + h * 128 + k;
        const bf16_t* QAp = (const bf16_t*)(ws + WS_QA) + (size_t)(t0 + 16 * tg) * 512 + h * 128 + k;
        float lf[16], q[16]; float part = 0.f;
#pragma unroll
        for (int i = 0; i < 16; ++i) { lf[i] = bf2f(LFp[(size_t)i * 512]); if (FULL) q[i] = bf2f(QAp[(size_t)i * 512]); part += lf[i]; }
        PART[tg * 128 + k] = part;
        __syncthreads();
        const float p0 = PART[k], p1 = PART[128 + k], p2 = PART[256 + k], p3 = PART[384 + k];
        const float bmid = p0 + p1, total = bmid + p2 + p3;
        float run = (tg > 0 ? p0 : 0.f) + (tg > 1 ? p1 : 0.f) + (tg > 2 ? p2 : 0.f);
#pragma unroll
        for (int i = 0; i < 16; ++i) { run += lf[i]; const float f = __expf(lf[i]), kk = 1.f - f; const int t = 16 * tg + i;
            if (FULL) { QT[t * 136 + k] = f2bf(q[i] * __expf(run - bmid)); KT[t * 136 + k] = f2bf(kk * __expf(bmid - run)); QH[t * 136 + k] = f2bf(q[i] * __expf(run)); }
            khv[i] = kk * __expf(total - run); }
        if (tg == 0) DEC[k] = __expf(total);
    } else {
        const float* GT = (const float*)(ws + WS_GATES) + (size_t)(t0 + lane) * 8;
        const float li = GT[h], lfg = GT[4 + h];
        float b = lfg;
#pragma unroll
        for (int o = 1; o < 64; o <<= 1) { const float x = __shfl_up(b, o); if (lane >= o) b += x; }
        const float a = li - b; float pm = a;
#pragma unroll
        for (int o = 1; o < 64; o <<= 1) { const float x = __shfl_up(pm, o); if (lane >= o) pm = fmaxf(pm, x); }
        const float M = fmaxf(pm, mcar), wi = __expf(mcar - M);
        const float M63 = __shfl(M, 63);
        const float wg = __expf(a - M63), dec = __expf(mcar - M63);
        if (FULL && w == 0) { SCA[lane] = a; SCM[lane] = M; SCWI[lane] = wi; SCE[lane] = __expf(-(b + M)); }
        if (tg == 0) DEC[k] = dec;
        float wq[4], wk[4], bq, bk;
        { const float* cw = P.in[11] + layer * 4096; const float* cb = P.in[12] + layer * 1024;
#pragma unroll
          for (int j = 0; j < 4; ++j) { wq[j] = cw[j * 1024 + h * 128 + k]; wk[j] = cw[j * 1024 + 512 + h * 128 + k]; }
          bq = cb[h * 128 + k]; bk = cb[512 + h * 128 + k]; }
        const bf16_t* CQp = (const bf16_t*)(ws + WS_CQ) + h * 128 + k; const bf16_t* CKp = (const bf16_t*)(ws + WS_CK) + h * 128 + k;
#pragma unroll
        for (int hf = 0; hf < 2; ++hf) {
            float rq[11], rkk[11];
#pragma unroll
            for (int i = 0; i < 11; ++i) { const int t = t0 + 16 * tg + 8 * hf - 3 + i; const bool ok = t >= 0; const size_t tt = ok ? (size_t)t : 0;
                const float kx = bf2f(CKp[tt * 512]); rkk[i] = ok ? kx : 0.f;
                if (FULL) { const float qx = bf2f(CQp[tt * 512]); rq[i] = ok ? qx : 0.f; } else rq[i] = 0.f; }
#pragma unroll
            for (int i = 0; i < 8; ++i) {
                const float kv = siluf_(bk + wk[0] * rkk[i] + wk[1] * rkk[i + 1] + wk[2] * rkk[i + 2] + wk[3] * rkk[i + 3]) * 0.08838834764831845f;
                const int t = 16 * tg + 8 * hf + i; const float wgt = __shfl(wg, t);
                if (FULL) { const float qv = siluf_(bq + wq[0] * rq[i] + wq[1] * rq[i + 1] + wq[2] * rq[i + 2] + wq[3] * rq[i + 3]); const float wit = __shfl(wi, t);
                    QT[t * 136 + k] = f2bf(qv); KT[t * 136 + k] = f2bf(kv); QH[t * 136 + k] = f2bf(qv * wit); }
                khv[8 * hf + i] = kv * wgt; }
        }
    }
    { unsigned char* kp = lds + CH_KHT + k * 144 + tg * 32; *(u32x4*)kp = pack8(khv); *(u32x4*)(kp + 16) = pack8(khv + 8); }
}

template <int MODE  >
DI void chain_unit(const Params& P, unsigned char* lds, int layer, int batch, int h, int seg, unsigned* flags  ) {
    const int tid = opaque((int)threadIdx.x), lane = tid & 63, w = __builtin_amdgcn_readfirstlane(tid >> 6), fr = lane & 15, fq = lane >> 4;
    const int k = tid & 127, tg = w >> 1;
    unsigned char* ws = P.ws;
    float* OB = (float*)(lds + CH_OB); float* DEC = (float*)(lds + CH_DEC);
    float* NV = (float*)(lds + CH_NV); float* SCA = (float*)(lds + CH_SC); float* SCM = SCA + 64; float* SCWI = SCA + 128; float* SCE = SCA + 192;
    float* MC = (float*)(lds + CH_MC); float* DT = (float*)(lds + CH_DT); float* NL = (float*)(lds + CH_NL);
    bf16_t* Y = (bf16_t*)(ws + WS_Y);
    float* SIN = (float*)(ws + WS_STATE) + (size_t)((MODE * 4 + h) * NSEG) * SIN_FLOATS;
    if (MODE == 1) {
        float* SB = OB; float* SP = OB + 256;
        if (tid < 256) { const float* GT = (const float*)(ws + WS_GATES) + (size_t)(tid * 64) * 8; float b = 0.f, pm = -1e30f;
#pragma unroll 8
            for (int s = 0; s < 64; ++s) { b += GT[s * 8 + 4 + h]; pm = fmaxf(pm, GT[s * 8 + h] - b); }
            SB[tid] = b; SP[tid] = pm; }
        __syncthreads();
        if (tid == 0) { float m = 0.f;
#pragma unroll 1
            for (int c = 0; c < 256; ++c) { MC[c] = m; m = SB[c] + fmaxf(SP[c], m); } }
        __syncthreads();
    }
    f32x4 Sacc[8];
#pragma unroll
    for (int i = 0; i < 8; ++i) Sacc[i] = (f32x4){0.f, 0.f, 0.f, 0.f};
    float dtot = 1.f, nloc = 0.f;
    if (seg < NSEG - 1) {
#pragma unroll 1
        for (int cc = 0; cc < CPS; ++cc) {
            const int chunk = seg * CPS + cc, t0 = chunk * 64;
            const float mcar = (MODE == 1) ? MC[chunk] : 0.f;
            chain_prep<MODE, false>(P, lds, layer, h, t0, tid, lane, w, k, tg, mcar);
            __syncthreads();
            if (tid < 128) { const float d = DEC[tid]; dtot *= d;
                if (MODE == 1) { float sum = 0.f;
#pragma unroll
                    for (int c8 = 0; c8 < 8; ++c8) { float f[8]; unpack8(*(const u32x4*)(lds + CH_KHT + tid * 144 + c8 * 16), f);
#pragma unroll
                        for (int i = 0; i < 8; ++i) sum += f[i]; }
                    nloc = d * nloc + sum; } }
            bf16x8 vf[2];
#pragma unroll
            for (int ks = 0; ks < 2; ++ks) vf[ks] = *(const bf16x8*)(lds + CH_VT + (16 * w + fr) * 144 + (32 * ks + 8 * fq) * 2);
#pragma unroll
            for (int mb = 0; mb < 8; ++mb) { const f32x4 d = *(const f32x4*)(DEC + 16 * mb + 4 * fq); Sacc[mb] = Sacc[mb] * d;
#pragma unroll
                for (int ks = 0; ks < 2; ++ks) { const bf16x8 af = *(const bf16x8*)(lds + CH_KHT + (16 * mb + fr) * 144 + (32 * ks + 8 * fq) * 2); Sacc[mb] = mfma16(af, vf[ks], Sacc[mb]); } }
            __syncthreads();
        }
    }
    if (tid < 128) { DT[tid] = dtot; NL[tid] = nloc; }
    if (seg > 0) {
        if (tid == 0) { while (__hip_atomic_load(flags + seg, __ATOMIC_RELAXED, __HIP_MEMORY_SCOPE_AGENT) == 0u) __builtin_amdgcn_s_sleep(4); }
        __syncthreads();
        __threadfence();
    } else __syncthreads();
    {
        float* sin_me = SIN + (size_t)seg * SIN_FLOATS; float* sin_nx = SIN + (size_t)(seg + 1) * SIN_FLOATS;
        float n_in = 0.f;
        if (seg > 0 && tid < 128) n_in = __hip_atomic_load(sin_me + 16384 + tid, __ATOMIC_RELAXED, __HIP_MEMORY_SCOPE_AGENT);
#pragma unroll
        for (int mb = 0; mb < 8; ++mb) {
            f32x4 sin = (f32x4){0.f, 0.f, 0.f, 0.f};
            if (seg > 0) sin = *(const f32x4*)(sin_me + ((w * 8 + mb) * 64 + lane) * 4);
            if (seg < NSEG - 1) { const f32x4 d = *(const f32x4*)(DT + 16 * mb + 4 * fq); *(f32x4*)(sin_nx + ((w * 8 + mb) * 64 + lane) * 4) = d * sin + Sacc[mb]; }
            Sacc[mb] = sin;
        }
        if (tid < 128) { if (seg < NSEG - 1) sin_nx[16384 + tid] = dtot * n_in + nloc; if (MODE == 1) NV[tid] = n_in; }
        if (seg < NSEG - 1) {
            __threadfence();
            __syncthreads();
            if (tid == 0) __hip_atomic_store(flags + seg + 1, 1u, __ATOMIC_RELEASE, __HIP_MEMORY_SCOPE_AGENT);
        }
    }
    __syncthreads();
#pragma unroll 1
    for (int cc = 0; cc < CPS; ++cc) {
        const int chunk = seg * CPS + cc, t0 = chunk * 64;
        const float mcar = (MODE == 1) ? MC[chunk] : 0.f;
        chain_prep<MODE, true>(P, lds, layer, h, t0, tid, lane, w, k, tg, mcar);
        __syncthreads();
        {
            const int mb = w >> 1;
#pragma unroll
            for (int nn = 0; nn < 2; ++nn) { const int nb = (w & 1) * 2 + nn; f32x4 acc = (f32x4){0.f, 0.f, 0.f, 0.f};
                if (nb <= mb) {
#pragma unroll
                    for (int ks = 0; ks < 4; ++ks) { const bf16x8 af = *(const bf16x8*)(lds + CH_QT + (16 * mb + fr) * 272 + (32 * ks + 8 * fq) * 2);
                        const bf16x8 bfv = *(const bf16x8*)(lds + CH_KT + (16 * nb + fr) * 272 + (32 * ks + 8 * fq) * 2); acc = mfma16(af, bfv, acc); }
                }
                const int s = 16 * nb + fr; float as = 0.f; if (MODE == 1) as = SCA[s];
#pragma unroll
                for (int r = 0; r < 4; ++r) { const int t = 16 * mb + 4 * fq + r; float v = 0.f;
                    if (s <= t) { v = acc[r]; if (MODE == 1) v *= __expf(as - SCM[t]); }
                    ((bf16_t*)(lds + CH_AM))[t * 72 + s] = f2bf(v); }
            }
        }
        if (MODE == 1 && tid < 128) { float sum = 0.f;
#pragma unroll
            for (int c8 = 0; c8 < 8; ++c8) { float f[8]; unpack8(*(const u32x4*)(lds + CH_KHT + tid * 144 + c8 * 16), f);
#pragma unroll
                for (int i = 0; i < 8; ++i) sum += f[i]; }
            NV[((cc + 1) & 1) * 128 + tid] = DEC[tid] * NV[(cc & 1) * 128 + tid] + sum; }
        __syncthreads();
        {
            bf16x8 vf[2];
#pragma unroll
            for (int ks = 0; ks < 2; ++ks) vf[ks] = *(const bf16x8*)(lds + CH_VT + (16 * w + fr) * 144 + (32 * ks + 8 * fq) * 2);
            bf16x8 sb[4];
#pragma unroll
            for (int ks = 0; ks < 4; ++ks) { u32x4 pp; pp.x = pk2(Sacc[2 * ks][0], Sacc[2 * ks][1]); pp.y = pk2(Sacc[2 * ks][2], Sacc[2 * ks][3]);
                pp.z = pk2(Sacc[2 * ks + 1][0], Sacc[2 * ks + 1][1]); pp.w = pk2(Sacc[2 * ks + 1][2], Sacc[2 * ks + 1][3]); sb[ks] = __builtin_bit_cast(bf16x8, pp); }
#pragma unroll
            for (int mb = 0; mb < 4; ++mb) { f32x4 o = (f32x4){0.f, 0.f, 0.f, 0.f};
#pragma unroll
                for (int ks = 0; ks < 2; ++ks) { const bf16x8 af = *(const bf16x8*)(lds + CH_AM + (16 * mb + fr) * 144 + (32 * ks + 8 * fq) * 2); o = mfma16(af, vf[ks], o); }
#pragma unroll
                for (int ks = 0; ks < 4; ++ks) { const unsigned char* qp = lds + CH_QH + (16 * mb + fr) * 272 + (32 * ks + 4 * fq) * 2;
                    const s16x4 lo = *(const s16x4*)qp, hi = *(const s16x4*)(qp + 32); const bf16x8 af = __builtin_shufflevector(lo, hi, 0, 1, 2, 3, 4, 5, 6, 7); o = mfma16(af, sb[ks], o); }
#pragma unroll
                for (int r = 0; r < 4; ++r) OB[(16 * mb + 4 * fq + r) * 132 + 16 * w + fr] = o[r];
            }
#pragma unroll
            for (int mb = 0; mb < 8; ++mb) { const f32x4 d = *(const f32x4*)(DEC + 16 * mb + 4 * fq); Sacc[mb] = Sacc[mb] * d;
#pragma unroll
                for (int ks = 0; ks < 2; ++ks) { const bf16x8 af = *(const bf16x8*)(lds + CH_KHT + (16 * mb + fr) * 144 + (32 * ks + 8 * fq) * 2); Sacc[mb] = mfma16(af, vf[ks], Sacc[mb]); } }
        }
        __syncthreads();
        {
            const int t = tid >> 3, dc = tid & 7; float o[16];
#pragma unroll
            for (int i = 0; i < 4; ++i) { const f32x4 x = *(const f32x4*)(OB + t * 132 + 16 * dc + 4 * i); o[4 * i] = x.x; o[4 * i + 1] = x.y; o[4 * i + 2] = x.z; o[4 * i + 3] = x.w; }
            const size_t row = (size_t)(t0 + t);
            if (MODE == 1) {
                float f[8]; unpack8(*(const u32x4*)(lds + CH_AM + t * 144 + dc * 16), f);
                float rsum = 0.f;
#pragma unroll
                for (int i = 0; i < 8; ++i) rsum += f[i];
                float qn = 0.f; const float* nv = NV + (cc & 1) * 128 + 16 * dc;
                float qf8[8]; unpack8(*(const u32x4*)(lds + CH_QT + t * 272 + dc * 32), qf8);
#pragma unroll
                for (int i = 0; i < 8; ++i) qn += qf8[i] * nv[i];
                unpack8(*(const u32x4*)(lds + CH_QT + t * 272 + dc * 32 + 16), qf8);
#pragma unroll
                for (int i = 0; i < 8; ++i) qn += qf8[i] * nv[8 + i];
                rsum += __shfl_xor(rsum, 1); rsum += __shfl_xor(rsum, 2); rsum += __shfl_xor(rsum, 4);
                qn += __shfl_xor(qn, 1); qn += __shfl_xor(qn, 2); qn += __shfl_xor(qn, 4);
                const float nq = rsum + SCWI[t] * qn; const float den = 1.f / fmaxf(fabsf(nq), SCE[t]);
                const bf16_t* ogp = (const bf16_t*)(ws + WS_OG) + row * 512 + h * 128 + 16 * dc; float og[16];
                unpack8(*(const u32x4*)ogp, og); unpack8(*(const u32x4*)(ogp + 8), og + 8);
#pragma unroll
                for (int i = 0; i < 16; ++i) o[i] = o[i] * den * og[i];
            }
            float ss = 0.f;
#pragma unroll
            for (int i = 0; i < 16; ++i) ss += o[i] * o[i];
            ss += __shfl_xor(ss, 1); ss += __shfl_xor(ss, 2); ss += __shfl_xor(ss, 4);
            const float rn = rsqrtf(ss * (1.f / 128.f) + EPS);
            const float* g = (MODE == 0 ? P.in[7] : P.in[13]) + layer * 128 + 16 * dc;
            bf16_t* yp = Y + row * DMIX + (MODE == 0 ? 0 : 1024) + h * 128 + 16 * dc; float gt[16];
            unpack8(*(const u32x4*)yp, gt); unpack8(*(const u32x4*)(yp + 8), gt + 8);
#pragma unroll
            for (int i = 0; i < 16; ++i) o[i] = o[i] * rn * g[i] * gt[i];
            *(u32x4*)yp = pack8(o); *(u32x4*)(yp + 8) = pack8(o + 8);
        }
        __syncthreads();
    }
}

#ifdef DIS_C0
#define ENA_C0(x)
#else
#define ENA_C0(x) x
#endif
#ifdef DIS_C1
#define ENA_C1(x)
#else
#define ENA_C1(x) x
#endif
#ifdef DIS_A2
#define ENA_A2(x)
#else
#define ENA_A2(x) x
#endif
#ifdef DIS_A1
#define ENA_A1(x)
#else
#define ENA_A1(x) x
#endif
#ifndef PROBE_SEL
#define PROBE_SEL 0
#endif
#if PROBE_SEL
#define STAMP(i) do { const unsigned long long n_ = wall_clock64(); tacc##i += n_ - tprev; tprev = n_; } while (0)
#else
#define STAMP(i) do {} while (0)
#endif
__global__ void __launch_bounds__(NTHR, 2) hymba_fwd(Params P) {
    extern __shared__ __attribute__((aligned(16))) unsigned char lds[];
    cg::grid_group grid = cg::this_grid();
    const int tid = opaque((int)threadIdx.x), bid = blockIdx.x, G = gridDim.x;
    unsigned char* ws = P.ws;
    unsigned* CTL = (unsigned*)(ws + WS_CTL);
    volatile int* s_unit = (volatile int*)(lds + LDS_UNIT_OFF);

#if PROBE_SEL
    unsigned long long tprev = wall_clock64(); const unsigned long long tstart = tprev; unsigned long long tacc0 = 0, tacc1 = 0, tacc2 = 0, tacc3 = 0, tacc4 = 0;
#endif
    phase0(P, lds);
    for (int b = 0; b < NBATCH; ++b) {
        for (int l = 0; l < 2; ++l) {
            const float* xold = (l == 0 ? P.in[0] : (const float*)P.out) + (size_t)b * MP * DM;
            prep_rows(P, xold, l);
            grid.sync(); STAMP(0);
            {
                if (G == 256) {
                    const int xg = bid & 7, jb = bid >> 3;
                    for (int i = jb; i < 480; i += 32) { const int hfm = i / 240, ii = i - hfm * 240; const int tm = 8 * xg + 4 * hfm + (ii & 3), tn = ii >> 2;
                        gemm_tile((const bf16_t*)(ws + WS_XB), DM, (const bf16_t*)(ws + WS_WIN) + (size_t)l * NIN * DM, DM, DM, tm * 256, tn * 128, lds, (const float*)(ws + WS_RSTD),
                                  [&](const float* T, const float* RS, int r0, int c0) { epi_inproj(P, T, RS, r0, c0, l, b); } GEPI_PASS); }
                } else {
                    const int nt_in = (MP / 256) * (NIN / 128);
                    for (int tile = bid; tile < nt_in; tile += G) { const int tm = tile / (NIN / 128), tn = tile % (NIN / 128);
                        gemm_tile((const bf16_t*)(ws + WS_XB), DM, (const bf16_t*)(ws + WS_WIN) + (size_t)l * NIN * DM, DM, DM, tm * 256, tn * 128, lds, (const float*)(ws + WS_RSTD),
                                  [&](const float* T, const float* RS, int r0, int c0) { epi_inproj(P, T, RS, r0, c0, l, b); } GEPI_PASS); }
                }
                if (b == 0 && l == 0) {
                    for (int r0 = bid; r0 < 32; r0 += G) { int r = r0; const int ll = r / 16; r -= ll * 16; const int tm = r / 8, tn = r % 8;
                        gemm_tile((const bf16_t*)(ws + WS_MNB), DM, (const bf16_t*)(ws + WS_WKV) + (size_t)ll * DM * DM, DM, DM, tm * 256, tn * 128, lds, nullptr,
                                  [&](const float* T, const float* RS, int r0_, int c0) { epi_kvmem(P, T, RS, r0_, c0, ll); } GEPI_PASS); }
                }
            }
#if PROBE_SEL >= 10
            grid.sync();
            { const unsigned long long tx0 = wall_clock64();
              if (G == 256) { const int xg = bid & 7, jb = bid >> 3;
                for (int i = jb; i < 480; i += 32) { const int hfm = i / 240, ii = i - hfm * 240; const int tm = 8 * xg + 4 * hfm + (ii & 3), tn = ii >> 2;
                    gemm_tile<PROBE_SEL - 9>((const bf16_t*)(ws + WS_XB), DM, (const bf16_t*)(ws + WS_WIN) + (size_t)l * NIN * DM, DM, DM, tm * 256, tn * 128, lds, nullptr,
                              [&](const float* T, const float* RS, int r0, int c0) { }); } }
              grid.sync();
              tacc4 += wall_clock64() - tx0; }
#endif
            grid.sync(); STAMP(1);
            {
                unsigned* ctr = CTL + 16 * (b * 2 + l);
#if PROBE_SEL
                const unsigned long long tq0 = wall_clock64();
#endif
                if (bid < 128) {
                    const int md = bid >> 6, hh = (bid >> 4) & 3, sg = bid & 15;
                    unsigned* fl = CTL + 128 + ((b * 2 + l) * 2 + md) * 64 + hh * 16;
                    if (md == 0) { ENA_C0(chain_unit<0>(P, lds, l, b, hh, sg, fl)); }
                    else { ENA_C1(chain_unit<1>(P, lds, l, b, hh, sg, fl)); }
#if PROBE_SEL
                    if (bid == ((PROBE_SEL == 6) ? 127 : 63)) tacc4 += wall_clock64() - tq0;
#endif
                }
                for (;;) {
                    if (tid == 0) *s_unit = (int)atomicAdd(ctr, 1u);
                    __syncthreads();
                    const int u = __builtin_amdgcn_readfirstlane(*s_unit);
                    __syncthreads();
                    if (u >= 512 + 256) break;
                    if (u < 512) { ENA_A2(attn_unit<2>(P, lds, l, b, u & 3, 127 - (u >> 2))); }
                    else { const int i = u - 512; ENA_A1(attn_unit<1>(P, lds, l, b, i & 3, i >> 2)); }
                }
#if PROBE_SEL
                if (bid == 200) tacc4 += wall_clock64() - tq0;
#endif
            }
            grid.sync(); STAMP(2);
            {
                const int nt = (MP / 256) * (DM / 128);
                float* outp = P.out + (size_t)b * MP * DM;
                for (int tile = bid; tile < nt; tile += G) { int tm = tile / 8, tn = tile % 8;
                    if (G == 256) { const int xg = bid & 7, jb = bid >> 3, i = jb + 32 * (tile / G); tm = 8 * xg + (i >> 3); tn = i & 7; }
                    gemm_tile((const bf16_t*)(ws + WS_Y), DMIX, (const bf16_t*)(ws + WS_WOUT) + (size_t)l * DM * DMIX, DMIX, DMIX, tm * 256, tn * 128, lds, nullptr,
                              [&](const float* T, const float* RS, int r0, int c0) { epi_outproj(T, xold, outp, r0, c0); } GEPI_PASS);
                }
            }
            grid.sync(); STAMP(3);
        }
    }
#if PROBE_SEL
    if (bid == ((PROBE_SEL == 7) ? 200 : (PROBE_SEL == 6) ? 127 : (PROBE_SEL == 5) ? 63 : 0) && tid == 0) {
        unsigned long long sel = (PROBE_SEL == 1) ? tacc0 : (PROBE_SEL == 2) ? tacc1 : (PROBE_SEL == 3) ? tacc2 : (PROBE_SEL == 4) ? tacc3 : tacc4;
        if (sel > 10000000ull) sel = 10000000ull;
        const unsigned long long target = 5000000ull + sel;
        while (wall_clock64() - tstart < target) __builtin_amdgcn_s_sleep(32);
    }
#endif
}

extern "C" void kernel_launch(void* const* d_in, const int* in_sizes, int n_in, void* d_out, int out_size, void* d_ws, size_t ws_size, hipStream_t stream) {
    static int grid = 0;
    if (grid == 0) {
        if (n_in != 18 || ws_size < WS_END) { fprintf(stderr, "kernel_launch: unexpected n_in %d or ws_size %zu < %zu\n", n_in, ws_size, (size_t)WS_END); grid = -1; return; }
        int dev = 0, cus = 0, per_cu = 0;
        hipGetDevice(&dev);
        hipDeviceGetAttribute(&cus, hipDeviceAttributeMultiprocessorCount, dev);
        hipFuncSetAttribute((const void*)hymba_fwd, hipFuncAttributeMaxDynamicSharedMemorySize, LDS_BYTES);
        hipOccupancyMaxActiveBlocksPerMultiprocessor(&per_cu, (const void*)hymba_fwd, NTHR, LDS_BYTES);
        if (per_cu < 1) per_cu = 1;
        grid = cus * per_cu;
    }
    if (grid < 0) return;
    Params p{};
    for (int i = 0; i < 18; ++i) p.in[i] = (const float*)d_in[i];
    p.out = (float*)d_out; p.ws = (unsigned char*)d_ws;
    for (int j = 0; j < 8; ++j) p.inv_freq[j] = (float)pow(500000.0, -(double)(2 * j) / 16.0);
    p.mode = 0; p.pad = 0;
    void* args[] = {&p};
    hipError_t e = hipLaunchCooperativeKernel((const void*)hymba_fwd, dim3(grid), dim3(NTHR), args, LDS_BYTES, stream);
    if (e != hipSuccess) fprintf(stderr, "cooperative launch failed: %s (grid %d)\n", hipGetErrorString(e), grid);
}
```

```cpp
#include <hip/hip_runtime.h>
#include <hip/hip_cooperative_groups.h>
#include <cstdio>
#include <cstdint>
#include <cmath>
namespace cg = cooperative_groups;
#ifndef PROBE_SEL
#define PROBE_SEL 0
#endif

#define DI __device__ __forceinline__
typedef unsigned short bf16_t;
typedef short bf16x8 __attribute__((ext_vector_type(8)));
typedef short s16x4 __attribute__((ext_vector_type(4)));
typedef float f32x2 __attribute__((ext_vector_type(2)));
typedef float f32x4 __attribute__((ext_vector_type(4)));
typedef float f32x16 __attribute__((ext_vector_type(16)));
typedef __bf16 bf16x2v __attribute__((ext_vector_type(2)));
typedef unsigned u32x2 __attribute__((ext_vector_type(2)));
typedef unsigned u32x4 __attribute__((ext_vector_type(4)));

constexpr int SEQ = 16384, DM = 1024, NBATCH = 2, MP = 16384;
constexpr int NIN = 7680, NINO = 7688, DMIX = 2048;
constexpr int NTHR = 512;
constexpr float EPS = 1e-6f;
constexpr int LDS_BYTES = 143360;
constexpr int LDS_UNIT_OFF = 143344;

constexpr size_t WS_CTL   = 0;
constexpr size_t WS_WIN   = 4096;
constexpr size_t WS_WOUT  = WS_WIN  + (size_t)2 * NIN * DM * 2;
constexpr size_t WS_WKV   = WS_WOUT + (size_t)2 * DM * DMIX * 2;
constexpr size_t WS_MNB   = WS_WKV  + (size_t)2 * DM * DM * 2;
constexpr size_t WS_KMB   = WS_MNB  + (size_t)512 * DM * 2;
constexpr size_t WS_VMT   = WS_KMB  + (size_t)2 * 512 * 512 * 2;
constexpr size_t WS_COS   = WS_VMT  + (size_t)2 * 2 * 512 * 256 * 2;
constexpr size_t WS_SIN   = WS_COS  + (size_t)32768 * 8 * 4;
constexpr size_t WS_LB    = WS_SIN  + (size_t)32768 * 8 * 4;
constexpr size_t WS_XB    = WS_LB   + 4096;
constexpr size_t WS_RSTD  = WS_XB   + (size_t)MP * DM * 2;
constexpr size_t WS_GATES = WS_RSTD + (size_t)MP * 4;
constexpr size_t SZ512    = (size_t)MP * 512 * 2;
constexpr size_t WS_QA    = WS_GATES + (size_t)MP * 8 * 4;
constexpr size_t WS_LF    = WS_QA + SZ512;
constexpr size_t WS_VAT   = WS_LF + SZ512;
constexpr size_t WS_QB    = WS_VAT + SZ512;
constexpr size_t WS_KB    = WS_QB + SZ512;
constexpr size_t WS_VBT   = WS_KB + SZ512;
constexpr size_t WS_CQ    = WS_VBT + SZ512;
constexpr size_t WS_CK    = WS_CQ + SZ512;
constexpr size_t WS_CVT   = WS_CK + SZ512;
constexpr size_t WS_OG    = WS_CVT + SZ512;
constexpr size_t WS_QX    = WS_OG + SZ512;
constexpr size_t WS_Y     = WS_QX + SZ512;
constexpr size_t WS_STATE = WS_Y + (size_t)MP * DMIX * 2;
constexpr size_t WS_END   = WS_STATE + (size_t)2 * 4 * 16 * (16384 + 128) * 4;

struct Params {
    const float* in[18];
    float* out;
    unsigned char* ws;
    float inv_freq[8];
    int mode;
    int pad;
};

DI float bf2f(bf16_t v) { return __uint_as_float(((unsigned)v) << 16); }
DI unsigned pk2(float lo, float hi) { f32x2 v = {lo, hi}; bf16x2v b = __builtin_convertvector(v, bf16x2v); return __builtin_bit_cast(unsigned, b); }
DI bf16_t f2bf(float x) { return (bf16_t)(pk2(x, 0.f) & 0xffffu); }
DI float wave_sum(float v) {
#pragma unroll
    for (int o = 1; o < 64; o <<= 1) v += __shfl_xor(v, o);
    return v;
}
DI float sigmoidf_(float x) { return 1.f / (1.f + __expf(-x)); }
DI float siluf_(float x) { return x / (1.f + __expf(-x)); }
DI f32x4 mfma16(bf16x8 a, bf16x8 b, f32x4 c) { return __builtin_amdgcn_mfma_f32_16x16x32_bf16(a, b, c, 0, 0, 0); }
DI f32x16 mfma32(bf16x8 a, bf16x8 b, f32x16 c) { return __builtin_amdgcn_mfma_f32_32x32x16_bf16(a, b, c, 0, 0, 0); }
DI int opaque(int x) { asm volatile("" : "+v"(x)); return x; }
DI int crow(int r, int h2) { return (r & 3) + 8 * (r >> 2) + 4 * h2; }
DI void unpack8(u32x4 u, float* f) {
    f[0] = __uint_as_float(u.x << 16); f[1] = __uint_as_float(u.x & 0xffff0000u);
    f[2] = __uint_as_float(u.y << 16); f[3] = __uint_as_float(u.y & 0xffff0000u);
    f[4] = __uint_as_float(u.z << 16); f[5] = __uint_as_float(u.z & 0xffff0000u);
    f[6] = __uint_as_float(u.w << 16); f[7] = __uint_as_float(u.w & 0xffff0000u);
}
DI u32x4 pack8(const float* f) { u32x4 o; o.x = pk2(f[0], f[1]); o.y = pk2(f[2], f[3]); o.z = pk2(f[4], f[5]); o.w = pk2(f[6], f[7]); return o; }

DI void transpose_tile(const float* src, int ldsrc, int srccol0, const float* g, bf16_t* dst, int lddst, int k0, int n0, float* T, int tid) {
    const int n = tid & 63, kk = tid >> 6;
#pragma unroll
    for (int i = 0; i < 8; ++i) { const int k = kk + 8 * i; float v = src[(size_t)(k0 + k) * ldsrc + srccol0 + n]; if (g) v *= g[k0 + k]; T[k * 65 + n] = v; }
    __syncthreads();
    const int nn = tid >> 3, kc = tid & 7;
    float f[8];
#pragma unroll
    for (int i = 0; i < 8; ++i) f[i] = T[(8 * kc + i) * 65 + nn];
    *(u32x4*)(dst + (size_t)(n0 + nn) * lddst + k0 + 8 * kc) = pack8(f);
    __syncthreads();
}

DI void phase0(const Params& P, unsigned char* lds) {
    const int tid = opaque((int)threadIdx.x), bid = blockIdx.x, G = gridDim.x;
    unsigned char* ws = P.ws;
    float* T = (float*)lds;
    if (bid == 0) { for (int i = tid; i < 1024; i += NTHR) ((unsigned*)(ws + WS_CTL))[i] = 0u; }
    constexpr int T_IN = 16 * 120, T_OUT = 32 * 16, T_KV = 16 * 16;
    constexpr int NT = 2 * (T_IN + T_OUT + T_KV);
    for (int it = bid; it < NT; it += G) {
        int r = it; const int l = r / (T_IN + T_OUT + T_KV); r -= l * (T_IN + T_OUT + T_KV);
        if (r < T_IN) { const int kb = r / 120, nb = r % 120, n0 = nb * 64; const int sc = n0 < 6144 ? n0 : n0 + 8;
            transpose_tile(P.in[4] + (size_t)l * DM * NINO, NINO, sc, P.in[3] + l * DM, (bf16_t*)(ws + WS_WIN) + (size_t)l * NIN * DM, DM, kb * 64, n0, T, tid); continue; }
        r -= T_IN;
        if (r < T_OUT) { const int kb = r / 16, nb = r % 16;
            transpose_tile(P.in[17] + (size_t)l * DMIX * DM, DM, nb * 64, nullptr, (bf16_t*)(ws + WS_WOUT) + (size_t)l * DM * DMIX, DMIX, kb * 64, nb * 64, T, tid); continue; }
        r -= T_OUT;
        { const int kb = r / 16, nb = r % 16;
            transpose_tile(P.in[15] + (size_t)l * DM * DM, DM, nb * 64, P.in[14] + l * DM, (bf16_t*)(ws + WS_WKV) + (size_t)l * DM * DM, DM, kb * 64, nb * 64, T, tid); }
    }
    const int gt = bid * NTHR + tid, NG = G * NTHR;
    {
        const int* pos = (const int*)P.in[2];
        float* C = (float*)(ws + WS_COS); float* Sn = (float*)(ws + WS_SIN);
        for (int i = gt; i < 32768 * 8; i += NG) { const int row = i >> 3, j = i & 7; const float ang = (float)pos[row] * P.inv_freq[j]; C[i] = cosf(ang); Sn[i] = sinf(ang); }
    }
    { float* LB = (float*)(ws + WS_LB); const float* lg = P.in[6];
      for (int i = gt; i < 512; i += NG) { LB[i] = 0.f; LB[512 + i] = 1.f / (1.f + expf(lg[i] - lg[512 + i])); } }
    { const int lane = tid & 63, gw = (bid * NTHR + tid) >> 6, NGW = (G * NTHR) >> 6;
      for (int r = gw; r < 512; r += NGW) {
          const f32x4* xr = (const f32x4*)(P.in[1] + (size_t)r * DM) + lane; f32x4 v[4]; float s = 0.f;
#pragma unroll
          for (int j = 0; j < 4; ++j) { v[j] = xr[64 * j]; s += v[j].x * v[j].x + v[j].y * v[j].y + v[j].z * v[j].z + v[j].w * v[j].w; }
          const float rs = rsqrtf(wave_sum(s) * (1.f / DM) + EPS);
          u32x2* o = (u32x2*)((bf16_t*)(ws + WS_MNB) + (size_t)r * DM) + lane;
#pragma unroll
          for (int j = 0; j < 4; ++j) { u32x2 w; w.x = pk2(v[j].x * rs, v[j].y * rs); w.y = pk2(v[j].z * rs, v[j].w * rs); o[64 * j] = w; }
      } }
}

DI void prep_rows(const Params& P, const float* xsrc, int layer) {
    const int tid = opaque((int)threadIdx.x), lane = tid & 63, gw = (blockIdx.x * NTHR + tid) >> 6, NGW = (gridDim.x * NTHR) >> 6;
    unsigned char* ws = P.ws;
    const float* win = P.in[4] + (size_t)layer * DM * NINO; const float* ng = P.in[3] + layer * DM; const float* gb = P.in[5] + layer * 8;
    bf16_t* XB = (bf16_t*)(ws + WS_XB); float* RSTD = (float*)(ws + WS_RSTD); float* GATES = (float*)(ws + WS_GATES);
    for (int r = gw; r < MP; r += NGW) {
        const f32x4* xr = (const f32x4*)(xsrc + (size_t)r * DM) + lane; f32x4 v[4]; float s = 0.f;
#pragma unroll
        for (int j = 0; j < 4; ++j) { v[j] = xr[64 * j]; s += v[j].x * v[j].x + v[j].y * v[j].y + v[j].z * v[j].z + v[j].w * v[j].w; }
        const float rs = rsqrtf(wave_sum(s) * (1.f / DM) + EPS);
        u32x2* o = (u32x2*)(XB + (size_t)r * DM) + lane;
#pragma unroll
        for (int j = 0; j < 4; ++j) { u32x2 w; w.x = pk2(v[j].x, v[j].y); w.y = pk2(v[j].z, v[j].w); o[64 * j] = w; }
        float d[8];
#pragma unroll
        for (int g = 0; g < 8; ++g) d[g] = 0.f;
#pragma unroll
        for (int j = 0; j < 4; ++j) {
#pragma unroll
            for (int e = 0; e < 4; ++e) { const int k = 4 * lane + 256 * j + e; const float xv = v[j][e] * ng[k];
                const f32x4 w0 = *(const f32x4*)(win + (size_t)k * NINO + 6144); const f32x4 w1 = *(const f32x4*)(win + (size_t)k * NINO + 6148);
                d[0] += xv * w0.x; d[1] += xv * w0.y; d[2] += xv * w0.z; d[3] += xv * w0.w; d[4] += xv * w1.x; d[5] += xv * w1.y; d[6] += xv * w1.z; d[7] += xv * w1.w; }
        }
#pragma unroll
        for (int g = 0; g < 8; ++g) d[g] = wave_sum(d[g]) * rs;
        if (lane == 0) {
            RSTD[r] = rs;
            f32x4 gi, gf;
#pragma unroll
            for (int g = 0; g < 4; ++g) { gi[g] = d[g] + gb[g]; const float z = d[4 + g] + gb[4 + g]; gf[g] = fminf(z, 0.f) - log1pf(expf(-fabsf(z))); }
            *(f32x4*)(GATES + (size_t)r * 8) = gi; *(f32x4*)(GATES + (size_t)r * 8 + 4) = gf;
        }
    }
}

#if PROBE_SEL == 8
#define GEPI_ARG , unsigned long long& g_epi_ticks
#define GEPI_PASS , tacc4
#else
#define GEPI_ARG
#define GEPI_PASS
#endif
template <int VAR = 0, class Epi>
DI void gemm_tile(const bf16_t* A, int lda, const bf16_t* Bt, int ldb, int K, int row0, int col0, unsigned char* lds, const float* rowscale, const Epi& epi GEPI_ARG) {
    const int tid = opaque((int)threadIdx.x), lane = tid & 63, w = __builtin_amdgcn_readfirstlane(tid >> 6), wr = w >> 1, wc = w & 1, fr = lane & 15, fq = lane >> 4;
    constexpr int STG = 49152;
    f32x4 acc[4][4];
#pragma unroll
    for (int m = 0; m < 4; ++m)
#pragma unroll
        for (int n = 0; n < 4; ++n) acc[m][n] = (f32x4){0.f, 0.f, 0.f, 0.f};
    u32x4 ra0[4], rb0[2], ra1[4], rb1[2];
    float rsv = 1.f; if (rowscale && tid < 256) rsv = rowscale[row0 + tid];
    const int nt = K / 64;
    const int sc = tid & 7, sr0 = tid >> 3;
    const bf16_t* Ap = A + (size_t)(row0 + sr0) * lda + sc * 8;
    const bf16_t* Bp = Bt + (size_t)(col0 + sr0) * ldb + sc * 8;
    const int so = sr0 * 128 + ((sc ^ (sr0 & 7)) << 4);
#define G_LOAD(RA, RB, KT) do { _Pragma("unroll") for (int i = 0; i < 4; ++i) RA[i] = *(const u32x4*)(Ap + (size_t)(64 * i) * lda + (KT) * 64); \
        _Pragma("unroll") for (int i = 0; i < 2; ++i) RB[i] = *(const u32x4*)(Bp + (size_t)(64 * i) * ldb + (KT) * 64); } while (0)
#define G_STORE(RA, RB, BUF) do { unsigned char* NA_ = lds + (BUF) * STG; _Pragma("unroll") for (int i = 0; i < 4; ++i) *(u32x4*)(NA_ + so + i * 8192) = RA[i]; \
        _Pragma("unroll") for (int i = 0; i < 2; ++i) *(u32x4*)(NA_ + 32768 + so + i * 8192) = RB[i]; } while (0)
#define G_COMPUTE(BUF) do { const unsigned char* LA = lds + (BUF) * STG; const unsigned char* LB = LA + 32768; \
        _Pragma("unroll") for (int kk = 0; kk < 2; ++kk) { bf16x8 af[4], bfr[4]; const int ch = kk * 4 + fq; \
            _Pragma("unroll") for (int m = 0; m < 4; ++m) { const int r = wr * 64 + m * 16 + fr; af[m] = *(const bf16x8*)(LA + r * 128 + ((ch ^ (r & 7)) << 4)); } \
            _Pragma("unroll") for (int n = 0; n < 4; ++n) { const int r = wc * 64 + n * 16 + fr; bfr[n] = *(const bf16x8*)(LB + r * 128 + ((ch ^ (r & 7)) << 4)); } \
            _Pragma("unroll") for (int m = 0; m < 4; ++m) _Pragma("unroll") for (int n = 0; n < 4; ++n) acc[m][n] = mfma16(af[m], bfr[n], acc[m][n]); } } while (0)
    G_LOAD(ra0, rb0, 0);
    G_LOAD(ra1, rb1, 1);
    G_STORE(ra0, rb0, 0);
    __syncthreads();
    for (int t = 0; t < nt; t += 2) {
        if (VAR == 0 || VAR == 3) { G_LOAD(ra0, rb0, (t + 2 < nt ? t + 2 : nt - 1)); } __builtin_amdgcn_sched_barrier(0);
        G_COMPUTE(0);
        if (VAR != 2) { G_STORE(ra1, rb1, 1); }
        __syncthreads();
        if (VAR == 0 || VAR == 3) { G_LOAD(ra1, rb1, (t + 3 < nt ? t + 3 : nt - 1)); } __builtin_amdgcn_sched_barrier(0);
        G_COMPUTE(1);
        if (VAR != 2) { if (t + 2 < nt) G_STORE(ra0, rb0, 0); }
        __syncthreads();
    }
#undef G_LOAD
#undef G_STORE
#undef G_COMPUTE
    float* T = (float*)lds;
    if (VAR != 0) { f32x4 sm = (f32x4){0.f, 0.f, 0.f, 0.f};
#pragma unroll
        for (int m = 0; m < 4; ++m)
#pragma unroll
            for (int n = 0; n < 4; ++n) sm += acc[m][n];
        if (sm[0] + sm[1] + sm[2] + sm[3] == 12345.678f) T[tid] = sm[0];
        __syncthreads(); return; }
#pragma unroll
    for (int m = 0; m < 4; ++m)
#pragma unroll
        for (int n = 0; n < 4; ++n)
#pragma unroll
            for (int r = 0; r < 4; ++r) T[(wr * 64 + m * 16 + 4 * fq + r) * 132 + wc * 64 + n * 16 + fr] = acc[m][n][r];
    if (tid < 256) ((float*)(lds + 135168))[tid] = rsv;
    __syncthreads();
    epi(T, (const float*)(lds + 135168), row0, col0);
    __syncthreads();
}

DI void epi_inproj(const Params& P, const float* T, const float* RS, int row0, int col0, int layer, int batch) {
    const int tid = opaque((int)threadIdx.x); unsigned char* ws = P.ws;
    const int seg = col0 >> 9, cseg = col0 & 511;
    const bool transposed = (seg == 2 || seg == 6 || seg == 10);
    if (transposed) {
        bf16_t* dst = (bf16_t*)(ws + (seg == 2 ? WS_VAT : (seg == 6 ? WS_VBT : WS_CVT)));
#pragma unroll
        for (int j = 0; j < 8; ++j) { const int item = tid + NTHR * j, rc = item & 31, col = item >> 5; float f[8];
#pragma unroll
            for (int i = 0; i < 8; ++i) f[i] = T[(rc * 8 + i) * 132 + col] * RS[rc * 8 + i];
            *(u32x4*)(dst + (size_t)(cseg + col) * MP + row0 + rc * 8) = pack8(f); }
        return;
    }
    const float* LB = (const float*)(ws + WS_LB) + layer * 512;
    const float* COSt = (const float*)(ws + WS_COS); const float* SINt = (const float*)(ws + WS_SIN);
#pragma unroll
    for (int j = 0; j < 8; ++j) {
        const int item = tid + NTHR * j, r = item >> 4, ch = item & 15, row = row0 + r, c = cseg + ch * 8;
        const float rs = RS[r]; float v[8];
        { const f32x4 a = *(const f32x4*)(T + r * 132 + ch * 8), b = *(const f32x4*)(T + r * 132 + ch * 8 + 4);
          v[0] = a.x * rs; v[1] = a.y * rs; v[2] = a.z * rs; v[3] = a.w * rs; v[4] = b.x * rs; v[5] = b.y * rs; v[6] = b.z * rs; v[7] = b.w * rs; }
        bf16_t* dst = nullptr; size_t doff = (size_t)row * 512 + c;
        switch (seg) {
        case 0: { dst = (bf16_t*)(ws + WS_QA);
#pragma unroll
            for (int i = 0; i < 8; ++i) v[i] = siluf_(v[i]) * 0.08838834764831845f; } break;
        case 1: { dst = (bf16_t*)(ws + WS_LF);
#pragma unroll
            for (int i = 0; i < 8; ++i) { const float lb = LB[c + i]; v[i] = logf(fmaxf(lb + (1.f - lb) * sigmoidf_(v[i]), 1e-30f)); } } break;
        case 3: case 7: case 12: case 14: { dst = (bf16_t*)(ws + WS_Y); doff = (size_t)row * DMIX + (seg == 3 ? 0 : (seg == 7 ? 512 : (seg == 12 ? 1024 : 1536))) + c;
#pragma unroll
            for (int i = 0; i < 8; ++i) v[i] = siluf_(v[i]); } break;
        case 4: case 5: {
            dst = (bf16_t*)(ws + (seg == 4 ? WS_QB : WS_KB));
            float ss = 0.f;
#pragma unroll
            for (int i = 0; i < 8; ++i) ss += v[i] * v[i];
            ss += __shfl_xor(ss, 1); ss += __shfl_xor(ss, 2); ss += __shfl_xor(ss, 4);
            const float rn = rsqrtf(ss * (1.f / 64.f) + EPS);
            const float* g = P.in[8] + layer * 128 + (seg == 4 ? 0 : 64) + (ch & 7) * 8;
            const int grow = batch * SEQ + row; const int c7 = ch & 7;
            const float sc = (seg == 4) ? 0.125f * 1.4426950408889634f : 1.f;
#pragma unroll
            for (int i = 0; i < 8; ++i) {
                float y = v[i] * rn * g[i];
                const float part = __shfl_xor(y, 1);
                const float cs = COSt[grow * 8 + i], sn = SINt[grow * 8 + i];
                if (c7 == 0) y = y * cs - part * sn; else if (c7 == 1) y = y * cs + part * sn;
                v[i] = y * sc;
            } } break;
        case 8: dst = (bf16_t*)(ws + WS_CQ); break;
        case 9: dst = (bf16_t*)(ws + WS_CK); break;
        case 11: { dst = (bf16_t*)(ws + WS_OG);
#pragma unroll
            for (int i = 0; i < 8; ++i) v[i] = sigmoidf_(v[i]); } break;
        case 13: { dst = (bf16_t*)(ws + WS_QX);
            float ss = 0.f;
#pragma unroll
            for (int i = 0; i < 8; ++i) ss += v[i] * v[i];
            ss += __shfl_xor(ss, 1); ss += __shfl_xor(ss, 2); ss += __shfl_xor(ss, 4); ss += __shfl_xor(ss, 8);
            const float rn = rsqrtf(ss * (1.f / 128.f) + EPS) * (0.08838834764831845f * 1.4426950408889634f);
            const float* g = P.in[16] + layer * 256 + ch * 8;
#pragma unroll
            for (int i = 0; i < 8; ++i) v[i] = v[i] * rn * g[i]; } break;
        default: break;
        }
        *(u32x4*)(dst + doff) = pack8(v);
    }
}

DI void epi_kvmem(const Params& P, const float* T, const float* RS, int row0, int col0, int layer) {
    const int tid = opaque((int)threadIdx.x); unsigned char* ws = P.ws;
    if (col0 < 512) {
        bf16_t* dst = (bf16_t*)(ws + WS_KMB) + (size_t)layer * 512 * 512;
        const float* g = P.in[16] + layer * 256 + 128;
#pragma unroll
        for (int j = 0; j < 8; ++j) { const int item = tid + NTHR * j, r = item >> 4, ch = item & 15; float v[8];
            { const f32x4 a = *(const f32x4*)(T + r * 132 + ch * 8), b = *(const f32x4*)(T + r * 132 + ch * 8 + 4);
              v[0] = a.x; v[1] = a.y; v[2] = a.z; v[3] = a.w; v[4] = b.x; v[5] = b.y; v[6] = b.z; v[7] = b.w; }
            float ss = 0.f;
#pragma unroll
            for (int i = 0; i < 8; ++i) ss += v[i] * v[i];
            ss += __shfl_xor(ss, 1); ss += __shfl_xor(ss, 2); ss += __shfl_xor(ss, 4); ss += __shfl_xor(ss, 8);
            const float rn = rsqrtf(ss * (1.f / 128.f) + EPS);
#pragma unroll
            for (int i = 0; i < 8; ++i) v[i] = v[i] * rn * g[ch * 8 + i];
            *(u32x4*)(dst + (size_t)(row0 + r) * 512 + col0 + ch * 8) = pack8(v); }
    } else {
        const int b = row0 >> 8, m0 = row0 & 255;
        bf16_t* dst = (bf16_t*)(ws + WS_VMT) + (size_t)(layer * 2 + b) * 512 * 256;
#pragma unroll
        for (int j = 0; j < 8; ++j) { const int item = tid + NTHR * j, rc = item & 31, col = item >> 5; float f[8];
#pragma unroll
            for (int i = 0; i < 8; ++i) f[i] = T[(rc * 8 + i) * 132 + col];
            *(u32x4*)(dst + (size_t)(col0 - 512 + col) * 256 + m0 + rc * 8) = pack8(f); }
    }
}

DI void epi_outproj(const float* T, const float* xold, float* out, int grow0, int col0) {
    const int tid = opaque((int)threadIdx.x);
#pragma unroll
    for (int j = 0; j < 16; ++j) { const int item = tid + NTHR * j, r = item >> 5, c4 = item & 31;
        const size_t off = (size_t)(grow0 + r) * DM + col0 + c4 * 4;
        const f32x4 a = *(const f32x4*)(T + r * 132 + c4 * 4), x = *(const f32x4*)(xold + off);
        *(f32x4*)(out + off) = a + x; }
}

#if PROBE_SEL >= 20
#define AVAR_ARG , int VAR
#else
#define AVAR_ARG
#endif
template <int NCOMP>
DI void attn_unit(const Params& P, unsigned char* lds, int layer, int batch, int h, int qb AVAR_ARG) {
#if PROBE_SEL < 20
    constexpr int VAR = 0;
#endif
    constexpr int NS = (NCOMP == 2) ? 4 : 8;
    constexpr int STG = 64 * 272 + 128 * 136;
    const int tid = opaque((int)threadIdx.x), lane = tid & 63, w = __builtin_amdgcn_readfirstlane(tid >> 6), l31 = lane & 31, h2 = lane >> 5;
    unsigned char* ws = P.ws;
    const int comp = (NCOMP == 2) ? (w >> 2) : 0;
    const int q0 = (NCOMP == 2) ? qb * 128 : qb * 256;
    const int qw = (NCOMP == 2) ? q0 + 32 * (w & 3) : q0 + 32 * w;
    const bf16_t* Qsrc = (const bf16_t*)(ws + (NCOMP == 2 ? WS_QB : WS_QX));
    const bf16_t* Ksrc; const bf16_t* Vsrc; int ldv, nkt;
    if (NCOMP == 2) { Ksrc = (const bf16_t*)(ws + WS_KB) + h * 128; Vsrc = (const bf16_t*)(ws + WS_VBT) + (size_t)(h * 128) * MP; ldv = MP; nkt = 2 * qb + 2; }
    else { Ksrc = (const bf16_t*)(ws + WS_KMB) + (size_t)layer * 512 * 512 + (size_t)batch * 256 * 512 + h * 128;
           Vsrc = (const bf16_t*)(ws + WS_VMT) + (size_t)(layer * 2 + batch) * 512 * 256 + (size_t)(h * 128) * 256; ldv = 256; nkt = 4; }
    bf16x8 qf[NS];
    { const bf16_t* qp = Qsrc + (size_t)(qw + l31) * 512 + h * 128 + comp * 64 + 8 * h2;
#pragma unroll
      for (int s = 0; s < NS; ++s) qf[s] = *(const bf16x8*)(qp + 16 * s);
      asm volatile("s_waitcnt vmcnt(0)" ::: "memory");
#pragma unroll
      for (int s = 0; s < NS; ++s) asm volatile("" : "+v"(qf[s]));
      if (NCOMP == 1) {
#pragma unroll
          for (int s = 0; s < NS; ++s) *(bf16x8*)(lds + 69632 + (32 * w + l31) * 272 + (16 * s + 8 * h2) * 2) = qf[s]; } }
    f32x16 O[4];
#pragma unroll
    for (int d = 0; d < 4; ++d)
#pragma unroll
        for (int i = 0; i < 16; ++i) O[d][i] = 0.f;
    float mrun = -1e30f, lsum = 0.f;
    u32x4 rk0[2], rv0[2], rk1[2], rv1[2]; int kr[2], kc[2], vr[2], vc[2];
#pragma unroll
    for (int i = 0; i < 2; ++i) { const int c = tid + NTHR * i; kr[i] = c >> 4; kc[i] = c & 15; vr[i] = c >> 3; vc[i] = c & 7; }
#define A_LOAD(RK, RV, KT) do { const int kl_ = (KT); _Pragma("unroll") for (int i = 0; i < 2; ++i) { RK[i] = *(const u32x4*)(Ksrc + (size_t)(kl_ * 64 + kr[i]) * 512 + kc[i] * 8); \
        RV[i] = *(const u32x4*)(Vsrc + (size_t)vr[i] * ldv + kl_ * 64 + vc[i] * 8); } } while (0)
#define A_STORE(RK, RV, B) do { unsigned char* NK_ = lds + (B) * STG; _Pragma("unroll") for (int i = 0; i < 2; ++i) { *(u32x4*)(NK_ + kr[i] * 272 + kc[i] * 16) = RK[i]; \
        unsigned char* vp_ = NK_ + 64 * 272 + vr[i] * 136 + vc[i] * 16; *(u32x2*)vp_ = (u32x2){RV[i].x, RV[i].y}; *(u32x2*)(vp_ + 8) = (u32x2){RV[i].z, RV[i].w}; } } while (0)
#define A_COMPUTE(KT, B) do { const int kt = (KT); const unsigned char* LK = lds + (B) * STG; const unsigned char* LV = LK + 64 * 272; \
        const bool active = (NCOMP == 1) || (kt * 64 <= qw + 31); \
        if (active) { \
            f32x16 S[2]; \
        _Pragma("unroll") \
            for (int kb = 0; kb < 2; ++kb) \
        _Pragma("unroll") \
                for (int i = 0; i < 16; ++i) S[kb][i] = 0.f; \
        _Pragma("unroll") \
            for (int s = 0; s < NS; ++s) \
        _Pragma("unroll") \
                for (int kb = 0; kb < 2; ++kb) { const bf16x8 kf = *(const bf16x8*)(LK + (32 * kb + l31) * 272 + comp * 128 + (16 * s + 8 * h2) * 2); const bf16x8 qq = (NCOMP == 1) ? *(const bf16x8*)(lds + 69632 + (32 * w + l31) * 272 + (16 * s + 8 * h2) * 2) : qf[s]; __builtin_amdgcn_s_setprio(1); S[kb] = mfma32(kf, qq, S[kb]); __builtin_amdgcn_s_setprio(0); } \
            if (NCOMP == 2 && (kt * 64 + 63 > qw)) { \
                const int qpos = qw + l31; \
        _Pragma("unroll") \
                for (int kb = 0; kb < 2; ++kb) \
        _Pragma("unroll") \
                    for (int i = 0; i < 16; ++i) { const int key = kt * 64 + 32 * kb + crow(i, h2); if (key > qpos) S[kb][i] = -1e30f; } \
            } \
            float mx = S[0][0]; \
        _Pragma("unroll") \
            for (int kb = 0; kb < 2; ++kb) \
        _Pragma("unroll") \
                for (int i = 0; i < 16; ++i) mx = fmaxf(mx, S[kb][i]); \
            mx = fmaxf(mx, __shfl_xor(mx, 32)); \
            const float mnew = fmaxf(mrun, mx), alpha = __builtin_amdgcn_exp2f(mrun - mnew); \
            mrun = mnew; \
            float ps = 0.f; \
        _Pragma("unroll") \
            for (int kb = 0; kb < 2; ++kb) \
        _Pragma("unroll") \
                for (int i = 0; i < 16; ++i) { const float p = __builtin_amdgcn_exp2f(S[kb][i] - mnew); S[kb][i] = p; ps += p; } \
            lsum = lsum * alpha + ps; \
            if (__any(alpha != 1.f)) { \
        _Pragma("unroll") \
                for (int d = 0; d < 4; ++d) \
        _Pragma("unroll") \
                    for (int i = 0; i < 16; ++i) O[d][i] *= alpha; \
            } \
        _Pragma("unroll") \
            for (int kb = 0; kb < 2; ++kb) \
        _Pragma("unroll") \
                for (int s2 = 0; s2 < 2; ++s2) { \
                    u32x4 pp; pp.x = pk2(S[kb][8 * s2 + 0], S[kb][8 * s2 + 1]); pp.y = pk2(S[kb][8 * s2 + 2], S[kb][8 * s2 + 3]); pp.z = pk2(S[kb][8 * s2 + 4], S[kb][8 * s2 + 5]); pp.w = pk2(S[kb][8 * s2 + 6], S[kb][8 * s2 + 7]); \
                    const bf16x8 pf = __builtin_bit_cast(bf16x8, pp); \
        _Pragma("unroll") \
                    for (int d = 0; d < 4; ++d) { \
                        const unsigned char* vp = LV + (32 * d + l31) * 136 + (32 * kb + 16 * s2 + 4 * h2) * 2; \
                        const s16x4 lo = *(const s16x4*)vp, hi = *(const s16x4*)(vp + 16); \
                        const bf16x8 vf = __builtin_shufflevector(lo, hi, 0, 1, 2, 3, 4, 5, 6, 7); \
                        __builtin_amdgcn_s_setprio(1); O[d] = mfma32(vf, pf, O[d]); __builtin_amdgcn_s_setprio(0); \
                    } \
                } \
        } \
    } while (0)
    A_LOAD(rk0, rv0, 0);
    A_LOAD(rk1, rv1, 1);
    A_STORE(rk0, rv0, 0);
    __syncthreads();
    for (int kt2 = 0; kt2 < nkt; kt2 += 2) {
        if (VAR < 2) { A_LOAD(rk0, rv0, (kt2 + 2 < nkt ? kt2 + 2 : nkt - 1)); } __builtin_amdgcn_sched_barrier(0);
        A_COMPUTE(kt2, 0);
        if (VAR < 2) { A_STORE(rk1, rv1, 1); }
        __syncthreads();
        if (VAR < 2) { A_LOAD(rk1, rv1, (kt2 + 3 < nkt ? kt2 + 3 : nkt - 1)); } __builtin_amdgcn_sched_barrier(0);
        A_COMPUTE(kt2 + 1, 1);
        if (VAR < 2) { if (kt2 + 2 < nkt) A_STORE(rk0, rv0, 0); }
        __syncthreads();
    }
#undef A_LOAD
#undef A_STORE
#undef A_COMPUTE
    if (VAR != 0) { float sm = lsum; _Pragma("unroll") for (int d = 0; d < 4; ++d) _Pragma("unroll") for (int i = 0; i < 16; ++i) sm += O[d][i];
        if (sm == 12345.678f) ((float*)lds)[tid] = sm; __syncthreads(); return; }
    const float inv = 1.f / (lsum + __shfl_xor(lsum, 32));
#pragma unroll
    for (int d = 0; d < 4; ++d)
#pragma unroll
        for (int i = 0; i < 16; ++i) O[d][i] *= inv;
    bf16_t* Y = (bf16_t*)(ws + WS_Y);
    if (NCOMP == 1) {
        bf16_t* yp = Y + (size_t)(qw + l31) * DMIX + 1536 + h * 128;
#pragma unroll
        for (int d = 0; d < 4; ++d)
#pragma unroll
            for (int g = 0; g < 4; ++g) { const int dv = 32 * d + 8 * g + 4 * h2; const u32x2 gt = *(const u32x2*)(yp + dv);
                u32x2 o; o.x = pk2(O[d][4 * g + 0] * __uint_as_float(gt.x << 16), O[d][4 * g + 1] * __uint_as_float(gt.x & 0xffff0000u));
                o.y = pk2(O[d][4 * g + 2] * __uint_as_float(gt.y << 16), O[d][4 * g + 3] * __uint_as_float(gt.y & 0xffff0000u));
                *(u32x2*)(yp + dv) = o; }
        __syncthreads();
        return;
    }
    float* X = (float*)lds;
    const int ql = 32 * (w & 3) + l31;
    if (comp == 1) {
#pragma unroll
        for (int d = 0; d < 4; ++d)
#pragma unroll
            for (int i = 0; i < 16; ++i) X[ql * 132 + 32 * d + crow(i, h2)] = O[d][i];
    }
    __syncthreads();
    const float* lp = P.in[9] + layer * 256;
    float lam;
    { const float a = wave_sum(lp[lane] * lp[64 + lane]), b = wave_sum(lp[128 + lane] * lp[192 + lane]);
      const float lam_init = 0.8f - 0.6f * expf(-0.3f * (float)layer); lam = expf(a) - expf(b) + lam_init; }
    if (comp == 0) {
#pragma unroll
        for (int d = 0; d < 4; ++d)
#pragma unroll
            for (int i = 0; i < 16; ++i) { const int a = ql * 132 + 32 * d + crow(i, h2); X[a] = O[d][i] - lam * X[a]; }
    }
    __syncthreads();
    {
        const float lam_init = 0.8f - 0.6f * expf(-0.3f * (float)layer);
        const float* g = P.in[10] + layer * 128;
#pragma unroll
        for (int j = 0; j < 4; ++j) { const int item = tid + NTHR * j, r = item >> 4, ch = item & 15; float v[8];
            { const f32x4 a = *(const f32x4*)(X + r * 132 + ch * 8), b = *(const f32x4*)(X + r * 132 + ch * 8 + 4);
              v[0] = a.x; v[1] = a.y; v[2] = a.z; v[3] = a.w; v[4] = b.x; v[5] = b.y; v[6] = b.z; v[7] = b.w; }
            float ss = 0.f;
#pragma unroll
            for (int i = 0; i < 8; ++i) ss += v[i] * v[i];
            ss += __shfl_xor(ss, 1); ss += __shfl_xor(ss, 2); ss += __shfl_xor(ss, 4); ss += __shfl_xor(ss, 8);
            const float rn = rsqrtf(ss * (1.f / 128.f) + EPS) * (1.f - lam_init);
            bf16_t* yp = Y + (size_t)(q0 + r) * DMIX + 512 + h * 128 + ch * 8; float gt[8]; unpack8(*(const u32x4*)yp, gt);
#pragma unroll
            for (int i = 0; i < 8; ++i) v[i] = v[i] * rn * g[ch * 8 + i] * gt[i];
            *(u32x4*)yp = pack8(v); }
    }
    __syncthreads();
}

constexpr int NSEG = 16, CPS = 16;
constexpr int SIN_FLOATS = 16384 + 128;
constexpr int CH_QT = 0, CH_KT = 17408, CH_QH = 34816, CH_KHT = 52224, CH_VT = 70656, CH_AM = 89088, CH_OB = 98304, CH_PART = 132096,
              CH_DEC = 134144, CH_NV = 134656  , CH_SC = 135680  , CH_MC = 136704  ,
              CH_DT = 137728  , CH_NL = 138240  ;

template <int MODE, bool FULL>
DI void chain_prep(const Params& P, unsigned char* lds, int layer, int h, int t0, int tid, int lane, int w, int k, int tg, float mcar) {
    unsigned char* ws = P.ws;
    bf16_t* QT = (bf16_t*)(lds + CH_QT); bf16_t* KT = (bf16_t*)(lds + CH_KT); bf16_t* QH = (bf16_t*)(lds + CH_QH);
    float* PART = (float*)(lds + CH_PART); float* DEC = (float*)(lds + CH_DEC);
    float* SCA = (float*)(lds + CH_SC); float* SCM = SCA + 64; float* SCWI = SCA + 128; float* SCE = SCA + 192;
    const bf16_t* Vsrc = (const bf16_t*)(ws + (MODE == 0 ? WS_VAT : WS_CVT)) + (size_t)(h * 128) * MP;
#pragma unroll
    for (int i = 0; i < 2; ++i) { const int c = tid + NTHR * i, dv = c >> 3, ch = c & 7;
        *(u32x4*)(lds + CH_VT + dv * 144 + ch * 16) = *(const u32x4*)(Vsrc + (size_t)dv * MP + t0 + ch * 8); }
    float khv[16];
    if (MODE == 0) {
        const bf16_t* LFp = (const bf16_t*)(ws + WS_LF) + (size_t)(t0 + 16 * tg) * 512 + h * 128 + k;
        const bf16_t* QAp = (const bf16_t*)(ws + WS_QA) + (size_t)(t0 + 16 * tg) * 512 + h * 128 + k;
        float lf[16], q[16]; float part = 0.f;
#pragma unroll
        for (int i = 0; i < 16; ++i) { lf[i] = bf2f(LFp[(size_t)i * 512]); if (FULL) q[i] = bf2f(QAp[(size_t)i * 512]); part += lf[i]; }
        PART[tg * 128 + k] = part;
        __syncthreads();
        const float p0 = PART[k], p1 = PART[128 + k], p2 = PART[256 + k], p3 = PART[384 + k];
        const float bmid = p0 + p1, total = bmid + p2 + p3;
        float run = (tg > 0 ? p0 : 0.f) + (tg > 1 ? p1 : 0.f) + (tg > 2 ? p2 : 0.f);
#pragma unroll
        for (int i = 0; i < 16; ++i) { run += lf[i]; const float f = __expf(lf[i]), kk = 1.f - f; const int t = 16 * tg + i;
            if (FULL) { QT[t * 136 + k] = f2bf(q[i] * __expf(run - bmid)); KT[t * 136 + k] = f2bf(kk * __expf(bmid - run)); QH[t * 136 + k] = f2bf(q[i] * __expf(run)); }
            khv[i] = kk * __expf(total - run); }
        if (tg == 0) DEC[k] = __expf(total);
    } else {
        const float* GT = (const float*)(ws + WS_GATES) + (size_t)(t0 + lane) * 8;
        const float li = GT[h], lfg = GT[4 + h];
        float b = lfg;
#pragma unroll
        for (int o = 1; o < 64; o <<= 1) { const float x = __shfl_up(b, o); if (lane >= o) b += x; }
        const float a = li - b; float pm = a;
#pragma unroll
        for (int o = 1; o < 64; o <<= 1) { const float x = __shfl_up(pm, o); if (lane >= o) pm = fmaxf(pm, x); }
        const float M = fmaxf(pm, mcar), wi = __expf(mcar - M);
        const float M63 = __shfl(M, 63);
        const float wg = __expf(a - M63), dec = __expf(mcar - M63);
        if (FULL && w == 0) { SCA[lane] = a; SCM[lane] = M; SCWI[lane] = wi; SCE[lane] = __expf(-(b + M)); }
        if (tg == 0) DEC[k] = dec;
        float wq[4], wk[4], bq, bk;
        { const float* cw = P.in[11] + layer * 4096; const float* cb = P.in[12] + layer * 1024;
#pragma unroll
          for (int j = 0; j < 4; ++j) { wq[j] = cw[j * 1024 + h * 128 + k]; wk[j] = cw[j * 1024 + 512 + h * 128 + k]; }
          bq = cb[h * 128 + k]; bk = cb[512 + h * 128 + k]; }
        const bf16_t* CQp = (const bf16_t*)(ws + WS_CQ) + h * 128 + k; const bf16_t* CKp = (const bf16_t*)(ws + WS_CK) + h * 128 + k;
#pragma unroll
        for (int hf = 0; hf < 2; ++hf) {
            float rq[11], rkk[11];
#pragma unroll
            for (int i = 0; i < 11; ++i) { const int t = t0 + 16 * tg + 8 * hf - 3 + i; const bool ok = t >= 0; const size_t tt = ok ? (size_t)t : 0;
                const float kx = bf2f(CKp[tt * 512]); rkk[i] = ok ? kx : 0.f;
                if (FULL) { const float qx = bf2f(CQp[tt * 512]); rq[i] = ok ? qx : 0.f; } else rq[i] = 0.f; }
#pragma unroll
            for (int i = 0; i < 8; ++i) {
                const float kv = siluf_(bk + wk[0] * rkk[i] + wk[1] * rkk[i + 1] + wk[2] * rkk[i + 2] + wk[3] * rkk[i + 3]) * 0.08838834764831845f;
                const int t = 16 * tg + 8 * hf + i; const float wgt = __shfl(wg, t);
                if (FULL) { const float qv = siluf_(bq + wq[0] * rq[i] + wq[1] * rq[i + 1] + wq[2] * rq[i + 2] + wq[3] * rq[i + 3]); const float wit = __shfl(wi, t);
                    QT[t * 136 + k] = f2bf(qv); KT[t * 136 + k] = f2bf(kv); QH[t * 136 + k] = f2bf(qv * wit); }
                khv[8 * hf + i] = kv * wgt; }
        }
    }
    { unsigned char* kp = lds + CH_KHT + k * 144 + tg * 32; *(u32x4*)kp = pack8(khv); *(u32x4*)(kp + 16) = pack8(khv + 8); }
}

template <int MODE  >
DI void chain_unit(const Params& P, unsigned char* lds, int layer, int batch, int h, int seg, unsigned* flags  ) {
    const int tid = opaque((int)threadIdx.x), lane = tid & 63, w = __builtin_amdgcn_readfirstlane(tid >> 6), fr = lane & 15, fq = lane >> 4;
    const int k = tid & 127, tg = w >> 1;
    unsigned char* ws = P.ws;
    float* OB = (float*)(lds + CH_OB); float* DEC = (float*)(lds + CH_DEC);
    float* NV = (float*)(lds + CH_NV); float* SCA = (float*)(lds + CH_SC); float* SCM = SCA + 64; float* SCWI = SCA + 128; float* SCE = SCA + 192;
    float* MC = (float*)(lds + CH_MC); float* DT = (float*)(lds + CH_DT); float* NL = (float*)(lds + CH_NL);
    bf16_t* Y = (bf16_t*)(ws + WS_Y);
    float* SIN = (float*)(ws + WS_STATE) + (size_t)((MODE * 4 + h) * NSEG) * SIN_FLOATS;
    if (MODE == 1) {
        float* SB = OB; float* SP = OB + 256;
        if (tid < 256) { const float* GT = (const float*)(ws + WS_GATES) + (size_t)(tid * 64) * 8; float b = 0.f, pm = -1e30f;
#pragma unroll 8
            for (int s = 0; s < 64; ++s) { b += GT[s * 8 + 4 + h]; pm = fmaxf(pm, GT[s * 8 + h] - b); }
            SB[tid] = b; SP[tid] = pm; }
        __syncthreads();
        if (tid == 0) { float m = 0.f;
#pragma unroll 1
            for (int c = 0; c < 256; ++c) { MC[c] = m; m = SB[c] + fmaxf(SP[c], m); } }
        __syncthreads();
    }
    f32x4 Sacc[8];
#pragma unroll
    for (int i = 0; i < 8; ++i) Sacc[i] = (f32x4){0.f, 0.f, 0.f, 0.f};
    float dtot = 1.f, nloc = 0.f;
    if (seg < NSEG - 1) {
#pragma unroll 1
        for (int cc = 0; cc < CPS; ++cc) {
            const int chunk = seg * CPS + cc, t0 = chunk * 64;
            const float mcar = (MODE == 1) ? MC[chunk] : 0.f;
            chain_prep<MODE, false>(P, lds, layer, h, t0, tid, lane, w, k, tg, mcar);
            __syncthreads();
            if (tid < 128) { const float d = DEC[tid]; dtot *= d;
                if (MODE == 1) { float sum = 0.f;
#pragma unroll
                    for (int c8 = 0; c8 < 8; ++c8) { float f[8]; unpack8(*(const u32x4*)(lds + CH_KHT + tid * 144 + c8 * 16), f);
#pragma unroll
                        for (int i = 0; i < 8; ++i) sum += f[i]; }
                    nloc = d * nloc + sum; } }
            bf16x8 vf[2];
#pragma unroll
            for (int ks = 0; ks < 2; ++ks) vf[ks] = *(const bf16x8*)(lds + CH_VT + (16 * w + fr) * 144 + (32 * ks + 8 * fq) * 2);
#pragma unroll
            for (int mb = 0; mb < 8; ++mb) { const f32x4 d = *(const f32x4*)(DEC + 16 * mb + 4 * fq); Sacc[mb] = Sacc[mb] * d;
#pragma unroll
                for (int ks = 0; ks < 2; ++ks) { const bf16x8 af = *(const bf16x8*)(lds + CH_KHT + (16 * mb + fr) * 144 + (32 * ks + 8 * fq) * 2); Sacc[mb] = mfma16(af, vf[ks], Sacc[mb]); } }
            __syncthreads();
        }
    }
    if (tid < 128) { DT[tid] = dtot; NL[tid] = nloc; }
    if (seg > 0) {
        if (tid == 0) { while (__hip_atomic_load(flags + seg, __ATOMIC_RELAXED, __HIP_MEMORY_SCOPE_AGENT) == 0u) __builtin_amdgcn_s_sleep(4); }
        __syncthreads();
        __threadfence();
    } else __syncthreads();
    {
        float* sin_me = SIN + (size_t)seg * SIN_FLOATS; float* sin_nx = SIN + (size_t)(seg + 1) * SIN_FLOATS;
        float n_in = 0.f;
        if (seg > 0 && tid < 128) n_in = __hip_atomic_load(sin_me + 16384 + tid, __ATOMIC_RELAXED, __HIP_MEMORY_SCOPE_AGENT);
#pragma unroll
        for (int mb = 0; mb < 8; ++mb) {
            f32x4 sin = (f32x4){0.f, 0.f, 0.f, 0.f};
            if (seg > 0) sin = *(const f32x4*)(sin_me + ((w * 8 + mb) * 64 + lane) * 4);
            if (seg < NSEG - 1) { const f32x4 d = *(const f32x4*)(DT + 16 * mb + 4 * fq); *(f32x4*)(sin_nx + ((w * 8 + mb) * 64 + lane) * 4) = d * sin + Sacc[mb]; }
            Sacc[mb] = sin;
        }
        if (tid < 128) { if (seg < NSEG - 1) sin_nx[16384 + tid] = dtot * n_in + nloc; if (MODE == 1) NV[tid] = n_in; }
        if (seg < NSEG - 1) {
            __threadfence();
            __syncthreads();
            if (tid == 0) __hip_atomic_store(flags + seg + 1, 1u, __ATOMIC_RELEASE, __HIP_MEMORY_SCOPE_AGENT);
        }
    }
    __syncthreads();
#pragma unroll 1
    for (int cc = 0; cc < CPS; ++cc) {
        const int chunk = seg * CPS + cc, t0 = chunk * 64;
        const float mcar = (MODE == 1) ? MC[chunk] : 0.f;
        chain_prep<MODE, true>(P, lds, layer, h, t0, tid, lane, w, k, tg, mcar);
        __syncthreads();
        {
            const int mb = w >> 1;
#pragma unroll
            for (int nn = 0; nn < 2; ++nn) { const int nb = (w & 1) * 2 + nn; f32x4 acc = (f32x4){0.f, 0.f, 0.f, 0.f};
                if (nb <= mb) {
#pragma unroll
                    for (int ks = 0; ks < 4; ++ks) { const bf16x8 af = *(const bf16x8*)(lds + CH_QT + (16 * mb + fr) * 272 + (32 * ks + 8 * fq) * 2);
                        const bf16x8 bfv = *(const bf16x8*)(lds + CH_KT + (16 * nb + fr) * 272 + (32 * ks + 8 * fq) * 2); acc = mfma16(af, bfv, acc); }
                }
                const int s = 16 * nb + fr; float as = 0.f; if (MODE == 1) as = SCA[s];
#pragma unroll
                for (int r = 0; r < 4; ++r) { const int t = 16 * mb + 4 * fq + r; float v = 0.f;
                    if (s <= t) { v = acc[r]; if (MODE == 1) v *= __expf(as - SCM[t]); }
                    ((bf16_t*)(lds + CH_AM))[t * 72 + s] = f2bf(v); }
            }
        }
        if (MODE == 1 && tid < 128) { float sum = 0.f;
#pragma unroll
            for (int c8 = 0; c8 < 8; ++c8) { float f[8]; unpack8(*(const u32x4*)(lds + CH_KHT + tid * 144 + c8 * 16), f);
#pragma unroll
                for (int i = 0; i < 8; ++i) sum += f[i]; }
            NV[((cc + 1) & 1) * 128 + tid] = DEC[tid] * NV[(cc & 1) * 128 + tid] + sum; }
        __syncthreads();
        {
            bf16x8 vf[2];
#pragma unroll
            for (int ks = 0; ks < 2; ++ks) vf[ks] = *(const bf16x8*)(lds + CH_VT + (16 * w + fr) * 144 + (32 * ks + 8 * fq) * 2);
            bf16x8 sb[4];
#pragma unroll
            for (int ks = 0; ks < 4; ++ks) { u32x4 pp; pp.x = pk2(Sacc[2 * ks][0], Sacc[2 * ks][1]); pp.y = pk2(Sacc[2 * ks][2], Sacc[2 * ks][3]);
                pp.z = pk2(Sacc[2 * ks + 1][0], Sacc[2 * ks + 1][1]); pp.w = pk2(Sacc[2 * ks + 1][2], Sacc[2 * ks + 1][3]); sb[ks] = __builtin_bit_cast(bf16x8, pp); }
#pragma unroll
            for (int mb = 0; mb < 4; ++mb) { f32x4 o = (f32x4){0.f, 0.f, 0.f, 0.f};
#pragma unroll
                for (int ks = 0; ks < 2; ++ks) { const bf16x8 af = *(const bf16x8*)(lds + CH_AM + (16 * mb + fr) * 144 + (32 * ks + 8 * fq) * 2); o = mfma16(af, vf[ks], o); }
#pragma unroll
                for (int ks = 0; ks < 4; ++ks) { const unsigned char* qp = lds + CH_QH + (16 * mb + fr) * 272 + (32 * ks + 4 * fq) * 2;
                    const s16x4 lo = *(const s16x4*)qp, hi = *(const s16x4*)(qp + 32); const bf16x8 af = __builtin_shufflevector(lo, hi, 0, 1, 2, 3, 4, 5, 6, 7); o = mfma16(af, sb[ks], o); }
#pragma unroll
                for (int r = 0; r < 4; ++r) OB[(16 * mb + 4 * fq + r) * 132 + 16 * w + fr] = o[r];
            }
#pragma unroll
            for (int mb = 0; mb < 8; ++mb) { const f32x4 d = *(const f32x4*)(DEC + 16 * mb + 4 * fq); Sacc[mb] = Sacc[mb] * d;
#pragma unroll
                for (int ks = 0; ks < 2; ++ks) { const bf16x8 af = *(const bf16x8*)(lds + CH_KHT + (16 * mb + fr) * 144 + (32 * ks + 8 * fq) * 2); Sacc[mb] = mfma16(af, vf[ks], Sacc[mb]); } }
        }
        __syncthreads();
        {
            const int t = tid >> 3, dc = tid & 7; float o[16];
#pragma unroll
            for (int i = 0; i < 4; ++i) { const f32x4 x = *(const f32x4*)(OB + t * 132 + 16 * dc + 4 * i); o[4 * i] = x.x; o[4 * i + 1] = x.y; o[4 * i + 2] = x.z; o[4 * i + 3] = x.w; }
            const size_t row = (size_t)(t0 + t);
            if (MODE == 1) {
                float f[8]; unpack8(*(const u32x4*)(lds + CH_AM + t * 144 + dc * 16), f);
                float rsum = 0.f;
#pragma unroll
                for (int i = 0; i < 8; ++i) rsum += f[i];
                float qn = 0.f; const float* nv = NV + (cc & 1) * 128 + 16 * dc;
                float qf8[8]; unpack8(*(const u32x4*)(lds + CH_QT + t * 272 + dc * 32), qf8);
#pragma unroll
                for (int i = 0; i < 8; ++i) qn += qf8[i] * nv[i];
                unpack8(*(const u32x4*)(lds + CH_QT + t * 272 + dc * 32 + 16), qf8);
#pragma unroll
                for (int i = 0; i < 8; ++i) qn += qf8[i] * nv[8 + i];
                rsum += __shfl_xor(rsum, 1); rsum += __shfl_xor(rsum, 2); rsum += __shfl_xor(rsum, 4);
                qn += __shfl_xor(qn, 1); qn += __shfl_xor(qn, 2); qn += __shfl_xor(qn, 4);
                const float nq = rsum + SCWI[t] * qn; const float den = 1.f / fmaxf(fabsf(nq), SCE[t]);
                const bf16_t* ogp = (const bf16_t*)(ws + WS_OG) + row * 512 + h * 128 + 16 * dc; float og[16];
                unpack8(*(const u32x4*)ogp, og); unpack8(*(const u32x4*)(ogp + 8), og + 8);
#pragma unroll
                for (int i = 0; i < 16; ++i) o[i] = o[i] * den * og[i];
            }
            float ss = 0.f;
#pragma unroll
            for (int i = 0; i < 16; ++i) ss += o[i] * o[i];
            ss += __shfl_xor(ss, 1); ss += __shfl_xor(ss, 2); ss += __shfl_xor(ss, 4);
            const float rn = rsqrtf(ss * (1.f / 128.f) + EPS);
            const float* g = (MODE == 0 ? P.in[7] : P.in[13]) + layer * 128 + 16 * dc;
            bf16_t* yp = Y + row * DMIX + (MODE == 0 ? 0 : 1024) + h * 128 + 16 * dc; float gt[16];
            unpack8(*(const u32x4*)yp, gt); unpack8(*(const u32x4*)(yp + 8), gt + 8);
#pragma unroll
            for (int i = 0; i < 16; ++i) o[i] = o[i] * rn * g[i] * gt[i];
            *(u32x4*)yp = pack8(o); *(u32x4*)(yp + 8) = pack8(o + 8);
        }
        __syncthreads();
    }
}

#if PROBE_SEL >= 20
#define AVAR0 , pvar
#define AVAR1 , 0
#else
#define AVAR0
#define AVAR1
#endif
#ifdef DIS_C0
#define ENA_C0(x)
#else
#define ENA_C0(x) x
#endif
#ifdef DIS_C1
#define ENA_C1(x)
#else
#define ENA_C1(x) x
#endif
#ifdef DIS_A2
#define ENA_A2(x)
#else
#define ENA_A2(x) x
#endif
#ifdef DIS_A1
#define ENA_A1(x)
#else
#define ENA_A1(x) x
#endif
#if PROBE_SEL && PROBE_SEL < 10
#define STAMP(i) do { const unsigned long long n_ = wall_clock64(); tacc##i += n_ - tprev; tprev = n_; } while (0)
#else
#define STAMP(i) do {} while (0)
#endif
__global__ void __launch_bounds__(NTHR, 2) hymba_fwd(Params P) {
    extern __shared__ __attribute__((aligned(16))) unsigned char lds[];
    cg::grid_group grid = cg::this_grid();
    const int tid = opaque((int)threadIdx.x), bid = blockIdx.x, G = gridDim.x;
    unsigned char* ws = P.ws;
    unsigned* CTL = (unsigned*)(ws + WS_CTL);
    volatile int* s_unit = (volatile int*)(lds + LDS_UNIT_OFF);

#if PROBE_SEL
    unsigned long long tprev = wall_clock64(); const unsigned long long tstart = tprev; unsigned long long tacc0 = 0, tacc1 = 0, tacc2 = 0, tacc3 = 0, tacc4 = 0;
#endif
    phase0(P, lds);
    for (int b = 0; b < NBATCH; ++b) {
        for (int l = 0; l < 2; ++l) {
            const float* xold = (l == 0 ? P.in[0] : (const float*)P.out) + (size_t)b * MP * DM;
            prep_rows(P, xold, l);
            grid.sync(); STAMP(0);
            {
                if (G == 256) {
                    const int xg = bid & 7, jb = bid >> 3;
                    for (int i = jb; i < 480; i += 32) { const int hfm = i / 240, ii = i - hfm * 240; const int tm = 8 * xg + 4 * hfm + (ii & 3), tn = ii >> 2;
                        gemm_tile((const bf16_t*)(ws + WS_XB), DM, (const bf16_t*)(ws + WS_WIN) + (size_t)l * NIN * DM, DM, DM, tm * 256, tn * 128, lds, (const float*)(ws + WS_RSTD),
                                  [&](const float* T, const float* RS, int r0, int c0) { epi_inproj(P, T, RS, r0, c0, l, b); } GEPI_PASS); }
                } else {
                    const int nt_in = (MP / 256) * (NIN / 128);
                    for (int tile = bid; tile < nt_in; tile += G) { const int tm = tile / (NIN / 128), tn = tile % (NIN / 128);
                        gemm_tile((const bf16_t*)(ws + WS_XB), DM, (const bf16_t*)(ws + WS_WIN) + (size_t)l * NIN * DM, DM, DM, tm * 256, tn * 128, lds, (const float*)(ws + WS_RSTD),
                                  [&](const float* T, const float* RS, int r0, int c0) { epi_inproj(P, T, RS, r0, c0, l, b); } GEPI_PASS); }
                }
                if (b == 0 && l == 0) {
                    for (int r0 = bid; r0 < 32; r0 += G) { int r = r0; const int ll = r / 16; r -= ll * 16; const int tm = r / 8, tn = r % 8;
                        gemm_tile((const bf16_t*)(ws + WS_MNB), DM, (const bf16_t*)(ws + WS_WKV) + (size_t)ll * DM * DM, DM, DM, tm * 256, tn * 128, lds, nullptr,
                                  [&](const float* T, const float* RS, int r0_, int c0) { epi_kvmem(P, T, RS, r0_, c0, ll); } GEPI_PASS); }
                }
            }
#if PROBE_SEL >= 10
            grid.sync();
            { const unsigned long long tx0 = wall_clock64();
              if (G == 256) { const int xg = bid & 7, jb = bid >> 3;
                for (int i = jb; i < 480; i += 32) { const int hfm = i / 240, ii = i - hfm * 240; const int tm = 8 * xg + 4 * hfm + (ii & 3), tn = ii >> 2;
                    gemm_tile<PROBE_SEL - 9>((const bf16_t*)(ws + WS_XB), DM, (const bf16_t*)(ws + WS_WIN) + (size_t)l * NIN * DM, DM, DM, tm * 256, tn * 128, lds, nullptr,
                              [&](const float* T, const float* RS, int r0, int c0) { }); } }
              grid.sync();
              tacc4 += wall_clock64() - tx0; }
#endif
            grid.sync(); STAMP(1);
            {
                unsigned* ctr = CTL + 16 * (b * 2 + l);
#if PROBE_SEL
                const unsigned long long tq0 = wall_clock64();
#endif
                if (bid < 128) {
                    const int md = bid >> 6, hh = (bid >> 4) & 3, sg = bid & 15;
                    unsigned* fl = CTL + 128 + ((b * 2 + l) * 2 + md) * 64 + hh * 16;
                    if (md == 0) { ENA_C0(chain_unit<0>(P, lds, l, b, hh, sg, fl)); }
                    else { ENA_C1(chain_unit<1>(P, lds, l, b, hh, sg, fl)); }
#if PROBE_SEL
                    if (bid == ((PROBE_SEL == 6) ? 127 : 63)) tacc4 += wall_clock64() - tq0;
#endif
                }
#if PROBE_SEL >= 20
                for (int rep = 0; rep < 2; ++rep) {
                unsigned long long tx0 = 0;
                if (rep == 1) { grid.sync(); tx0 = wall_clock64(); ctr = CTL + 64 + 16 * (b * 2 + l); }
                const int pvar = rep ? (PROBE_SEL - 19) : 0; const int ulim = rep ? 512 : 768;
#else
                { const int ulim = 768;
#endif
                for (;;) {
                    if (tid == 0) *s_unit = (int)atomicAdd(ctr, 1u);
                    __syncthreads();
                    const int u = __builtin_amdgcn_readfirstlane(*s_unit);
                    __syncthreads();
                    if (u >= ulim) break;
                    if (u < 512) { ENA_A2(attn_unit<2>(P, lds, l, b, u & 3, 127 - (u >> 2) AVAR0)); }
                    else { const int i = u - 512; ENA_A1(attn_unit<1>(P, lds, l, b, i & 3, i >> 2 AVAR1)); }
                }
#if PROBE_SEL >= 20
                if (rep == 1) { grid.sync(); tacc4 += wall_clock64() - tx0; }
#endif
                }
#if PROBE_SEL
                if (bid == 200) tacc4 += wall_clock64() - tq0;
#endif
            }
            grid.sync(); STAMP(2);
            {
                const int nt = (MP / 256) * (DM / 128);
                float* outp = P.out + (size_t)b * MP * DM;
                for (int tile = bid; tile < nt; tile += G) { int tm = tile / 8, tn = tile % 8;
                    if (G == 256) { const int xg = bid & 7, jb = bid >> 3, i = jb + 32 * (tile / G); tm = 8 * xg + (i >> 3); tn = i & 7; }
                    gemm_tile((const bf16_t*)(ws + WS_Y), DMIX, (const bf16_t*)(ws + WS_WOUT) + (size_t)l * DM * DMIX, DMIX, DMIX, tm * 256, tn * 128, lds, nullptr,
                              [&](const float* T, const float* RS, int r0, int c0) { epi_outproj(T, xold, outp, r0, c0); } GEPI_PASS);
                }
            }
            grid.sync(); STAMP(3);
        }
    }
#if PROBE_SEL
    if (bid == ((PROBE_SEL == 7) ? 200 : (PROBE_SEL == 6) ? 127 : (PROBE_SEL == 5) ? 63 : 0) && tid == 0) {
        unsigned long long sel = (PROBE_SEL == 1) ? tacc0 : (PROBE_SEL == 2) ? tacc1 : (PROBE_SEL == 3) ? tacc2 : (PROBE_SEL == 4) ? tacc3 : tacc4;
        if (sel > 10000000ull) sel = 10000000ull;
        const unsigned long long target = 5000000ull + sel;
        while (wall_clock64() - tstart < target) __builtin_amdgcn_s_sleep(32);
    }
#endif
}

extern "C" void kernel_launch(void* const* d_in, const int* in_sizes, int n_in, void* d_out, int out_size, void* d_ws, size_t ws_size, hipStream_t stream) {
    static int grid = 0;
    if (grid == 0) {
        if (n_in != 18 || ws_size < WS_END) { fprintf(stderr, "kernel_launch: unexpected n_in %d or ws_size %zu < %zu\n", n_in, ws_size, (size_t)WS_END); grid = -1; return; }
        int dev = 0, cus = 0, per_cu = 0;
        hipGetDevice(&dev);
        hipDeviceGetAttribute(&cus, hipDeviceAttributeMultiprocessorCount, dev);
        hipFuncSetAttribute((const void*)hymba_fwd, hipFuncAttributeMaxDynamicSharedMemorySize, LDS_BYTES);
        hipOccupancyMaxActiveBlocksPerMultiprocessor(&per_cu, (const void*)hymba_fwd, NTHR, LDS_BYTES);
        if (per_cu < 1) per_cu = 1;
        grid = cus * per_cu;
    }
    if (grid < 0) return;
    Params p{};
    for (int i = 0; i < 18; ++i) p.in[i] = (const float*)d_in[i];
    p.out = (float*)d_out; p.ws = (unsigned char*)d_ws;
    for (int j = 0; j < 8; ++j) p.inv_freq[j] = (float)pow(500000.0, -(double)(2 * j) / 16.0);
    p.mode = 0; p.pad = 0;
    void* args[] = {&p};
    hipError_t e = hipLaunchCooperativeKernel((const void*)hymba_fwd, dim3(grid), dim3(NTHR), args, LDS_BYTES, stream);
    if (e != hipSuccess) fprintf(stderr, "cooperative launch failed: %s (grid %d)\n", hipGetErrorString(e), grid);
}
```
